# Optimizing an MI355X kernel written in HIP

```python
import math
import jax, jax.numpy as jnp
from jax import lax
import numpy as np

D_MODEL = 4096
BATCH = 1
SEQ = 8192
DEPTH = 1

HEAD_DIM = 128
DILATION_GROUPS = ((128, 1), (512, 4), (2048, 16))
A_HEADS_PER_GROUP = 6
N_HEADS_A = A_HEADS_PER_GROUP * len(DILATION_GROUPS)
N_HEADS_B = D_MODEL // HEAD_DIM - N_HEADS_A
WIDTH_A = N_HEADS_A * HEAD_DIM
WIDTH_B = N_HEADS_B * HEAD_DIM
WIDTH_A_OUT = A_HEADS_PER_GROUP * HEAD_DIM
IN_COLS = 3 * WIDTH_A + 3 * WIDTH_B + N_HEADS_B + 2 * D_MODEL
Q_BLOCK = 128
ALIBI_MAX_EXP = 8.0
PEER_HEADS = 8
N_KEYS = 128
N_EXPERTS = N_KEYS * N_KEYS
PEER_TOPK = 16
PEER_QDIM = 256
PEER_QHALF = PEER_QDIM // 2
PEER_CHUNK = 64
EPS = 1e-6
NEG = -1e30

kernel_name = "hybrid_dilated_fox_peer_block"


def _rmsnorm(x, gain):
    x32 = x.astype(jnp.float32)
    y = x32 * lax.rsqrt(jnp.mean(x32 * x32, axis=-1, keepdims=True) + EPS)
    return (y * gain.astype(jnp.float32)).astype(x.dtype)


def _alibi_slopes(n):
    return jnp.exp2(-ALIBI_MAX_EXP * jnp.arange(1, n + 1, dtype=jnp.float32) / n)


def _dilated_group(q, k, v, slopes, window, dilation):
    B, S, H, Dh = q.shape
    L = window // dilation
    span = dilation * L
    S_pad = -(-S // span) * span
    M = S_pad // dilation
    nb = M // L

    def to_blocks(t):
        t = jnp.pad(t, ((0, 0), (0, S_pad - S), (0, 0), (0, 0)))
        t = t.reshape(B, M, dilation, H, Dh).transpose(0, 2, 1, 3, 4)
        return t.reshape(B, dilation, nb, L, H, Dh)

    def with_prev(t):
        prev = jnp.pad(t[:, :, :-1], ((0, 0), (0, 0), (1, 0), (0, 0), (0, 0), (0, 0)))
        return jnp.concatenate([prev, t], axis=3)

    qb = to_blocks(q)
    kc = with_prev(to_blocks(k))
    vc = with_prev(to_blocks(v))
    s = jnp.einsum('bcnqhd,bcnkhd->bcnqhk', qb, kc).astype(jnp.float32) * (HEAD_DIM ** -0.5)
    qi = jnp.arange(L)[:, None]
    kj = jnp.arange(2 * L)[None, :]
    delta = qi + L - kj
    band = (delta >= 0) & (delta <= L)
    first = (jnp.arange(nb)[:, None, None] == 0) & (kj[None] < L)
    valid = band[None] & (~first)
    bias = -(slopes * dilation)[None, :, None] * delta[:, None, :].astype(jnp.float32)
    s = jnp.where(valid[:, :, None, :], s + bias, NEG)
    m = jnp.max(s, axis=-1)
    p = jnp.exp(s - m[..., None])
    l = jnp.sum(p, axis=-1)
    o = jnp.einsum('bcnqhk,bcnkhd->bcnqhd', p, vc.astype(jnp.float32))

    def from_blocks(t):
        t = t.reshape((B, dilation, M) + t.shape[4:])
        t = jnp.swapaxes(t, 1, 2)
        return t.reshape((B, S_pad) + t.shape[3:])[:, :S]

    return from_blocks(o), from_blocks(m), from_blocks(l)


def _dilated_mixture(q, k, v):
    slopes = _alibi_slopes(N_HEADS_A)
    res = []
    for g, (window, dilation) in enumerate(DILATION_GROUPS):
        sl = slice(g * A_HEADS_PER_GROUP, (g + 1) * A_HEADS_PER_GROUP)
        res.append(_dilated_group(q[:, :, sl], k[:, :, sl], v[:, :, sl], slopes[sl], window, dilation))
    m_star = jnp.max(jnp.stack([r[1] for r in res], 0), axis=0)
    num = 0.0
    den = 0.0
    for o, m, l in res:
        w = jnp.exp(m - m_star)
        num = num + w[..., None] * o
        den = den + w * l
    return (num / den[..., None]).astype(q.dtype)


def _forgetting_attention(q, k, v, logf):
    B, S, H, Dh = q.shape
    c = jnp.cumsum(logf.astype(jnp.float32), axis=1).transpose(0, 2, 1)
    kpos = jnp.arange(S)
    nb = S // Q_BLOCK

    def block(i):
        start = i * Q_BLOCK
        qb = lax.dynamic_slice_in_dim(q, start, Q_BLOCK, axis=1)
        cq = lax.dynamic_slice_in_dim(c, start, Q_BLOCK, axis=2)
        s = jnp.einsum('bqhd,bkhd->bhqk', qb, k).astype(jnp.float32) * (HEAD_DIM ** -0.5)
        s = s + cq[..., :, None] - c[:, :, None, :]
        qpos = start + jnp.arange(Q_BLOCK)
        s = jnp.where(kpos[None, :] <= qpos[:, None], s, NEG)
        p = jax.nn.softmax(s, axis=-1)
        return jnp.einsum('bhqk,bkhd->bqhd', p.astype(v.dtype), v)

    o = lax.map(block, jnp.arange(nb))
    return o.transpose(1, 0, 2, 3, 4).reshape(B, S, H, Dh)


def _peer(h, w_q, subkeys, u, v):
    B, S, D = h.shape
    q = (h @ w_q).reshape(B, S, PEER_HEADS, 2, PEER_QHALF)
    sc = jnp.einsum('bshcd,hcnd->bshcn', q, subkeys).astype(jnp.float32)
    s1, i1 = lax.top_k(sc[..., 0, :], PEER_TOPK)
    s2, i2 = lax.top_k(sc[..., 1, :], PEER_TOPK)
    cand = (s1[..., :, None] + s2[..., None, :]).reshape(B, S, PEER_HEADS, PEER_TOPK * PEER_TOPK)
    cidx = (i1[..., :, None] * N_KEYS + i2[..., None, :]).reshape(B, S, PEER_HEADS, PEER_TOPK * PEER_TOPK)
    top, pos = lax.top_k(cand, PEER_TOPK)
    eidx = jnp.take_along_axis(cidx, pos, axis=-1)
    gate = jax.nn.softmax(top, axis=-1)
    T = B * S
    K = PEER_HEADS * PEER_TOPK
    nc = T // PEER_CHUNK
    hc = h.reshape(nc, PEER_CHUNK, D)
    ec = eidx.reshape(nc, PEER_CHUNK, K)
    gc = gate.reshape(nc, PEER_CHUNK, K).astype(h.dtype)

    def chunk(args):
        hx, ex, gx = args
        a = jnp.einsum('ckd,cd->ck', u[ex], hx)
        act = jax.nn.gelu(a, approximate=False) * gx
        return jnp.einsum('ck,ckd->cd', act, v[ex])

    out = lax.map(chunk, (hc, ec, gc))
    return out.reshape(B, S, D)


def setup_inputs(seed: int = 0) -> dict:
    key = jax.random.key(seed)
    ks = jax.random.split(key, 20)
    f32 = jnp.float32
    nrm = lambda k, shape, scale: jax.random.normal(k, shape, f32) * scale
    return {
        "x": nrm(ks[0], (BATCH, SEQ, D_MODEL), 1.0),
        "norm1_gain": 1.0 + nrm(ks[1], (DEPTH, D_MODEL), 0.02),
        "w_in": nrm(ks[2], (DEPTH, D_MODEL, IN_COLS), D_MODEL ** -0.5),
        "b_forget": 3.0 + nrm(ks[3], (DEPTH, N_HEADS_B), 0.1),
        "q_norm_a": 1.0 + nrm(ks[4], (DEPTH, HEAD_DIM), 0.02),
        "k_norm_a": 1.0 + nrm(ks[5], (DEPTH, HEAD_DIM), 0.02),
        "q_norm_b": 1.0 + nrm(ks[6], (DEPTH, HEAD_DIM), 0.02),
        "k_norm_b": 1.0 + nrm(ks[7], (DEPTH, HEAD_DIM), 0.02),
        "w_up_a": nrm(ks[8], (DEPTH, WIDTH_A_OUT, D_MODEL), WIDTH_A_OUT ** -0.5),
        "w_up_b": nrm(ks[9], (DEPTH, WIDTH_B, D_MODEL), WIDTH_B ** -0.5),
        "w_out": nrm(ks[10], (DEPTH, D_MODEL, D_MODEL), D_MODEL ** -0.5),
        "norm2_gain": 1.0 + nrm(ks[11], (DEPTH, D_MODEL), 0.02),
        "w_peer_q": nrm(ks[12], (DEPTH, D_MODEL, PEER_HEADS * PEER_QDIM), D_MODEL ** -0.5),
        "peer_subkeys": nrm(ks[13], (DEPTH, PEER_HEADS, 2, N_KEYS, PEER_QHALF), PEER_QHALF ** -0.5),
        "peer_u": nrm(ks[14], (DEPTH, N_EXPERTS, D_MODEL), D_MODEL ** -0.5),
        "peer_v": nrm(ks[15], (DEPTH, N_EXPERTS, D_MODEL), D_MODEL ** -0.5),
    }


def reference(x, norm1_gain, w_in, b_forget, q_norm_a, k_norm_a, q_norm_b, k_norm_b,
              w_up_a, w_up_b, w_out, norm2_gain, w_peer_q, peer_subkeys, peer_u, peer_v):
    B, S, D = x.shape
    sizes = [WIDTH_A, WIDTH_A, WIDTH_A, WIDTH_B, WIDTH_B, WIDTH_B, N_HEADS_B, D_MODEL, D_MODEL]
    cuts = [int(c) for c in np.cumsum(sizes)[:-1]]
    h = x
    for layer in range(DEPTH):
        xn = _rmsnorm(h, norm1_gain[layer])
        proj = xn @ w_in[layer]
        qa, ka, va, qb, kb, vb, f_logit, ga, gb = jnp.split(proj, cuts, axis=-1)
        qa = _rmsnorm(qa.reshape(B, S, N_HEADS_A, HEAD_DIM), q_norm_a[layer])
        ka = _rmsnorm(ka.reshape(B, S, N_HEADS_A, HEAD_DIM), k_norm_a[layer])
        va = va.reshape(B, S, N_HEADS_A, HEAD_DIM)
        qb = _rmsnorm(qb.reshape(B, S, N_HEADS_B, HEAD_DIM), q_norm_b[layer])
        kb = _rmsnorm(kb.reshape(B, S, N_HEADS_B, HEAD_DIM), k_norm_b[layer])
        vb = vb.reshape(B, S, N_HEADS_B, HEAD_DIM)
        logf = jax.nn.log_sigmoid(f_logit.astype(jnp.float32) + b_forget[layer].astype(jnp.float32))
        y_a = _dilated_mixture(qa, ka, va).reshape(B, S, WIDTH_A_OUT)
        y_b = _forgetting_attention(qb, kb, vb, logf).reshape(B, S, WIDTH_B)
        merged = jax.nn.sigmoid(ga) * (y_a @ w_up_a[layer]) + jax.nn.sigmoid(gb) * (y_b @ w_up_b[layer])
        h = h + merged @ w_out[layer]
        hn = _rmsnorm(h, norm2_gain[layer])
        h = h + _peer(hn, w_peer_q[layer], peer_subkeys[layer], peer_u[layer], peer_v[layer])
    return h
```

```cpp
#include <hip/hip_runtime.h>
#include <cstdio>
#include <cstdint>

constexpr int S = 8192, DM = 4096, HD = 128;
constexpr int NHA = 18, NHB = 14, WA = NHA * HD  , WB = NHB * HD  , WAO = 6 * HD  ;
constexpr int INC = 3 * WA + 3 * WB + NHB + 2 * DM;
constexpr int C_QA = 0, C_KA = WA, C_VA = 2 * WA, C_QB = 3 * WA, C_KB = 3 * WA + WB, C_VB = 3 * WA + 2 * WB, C_F = 3 * WA + 3 * WB, C_GA = C_F + NHB, C_GB = C_GA + DM;
constexpr int YW = WAO + WB;
constexpr int PH = 8, NKEYS = 128, TOPK = 16, PQD = 256, PQH = 128, PQW = PH * PQD  , NEXP = NKEYS * NKEYS, PK = PH * TOPK  ;
constexpr float EPS = 1e-6f;
constexpr float LOG2E = 1.4426950408889634f;
constexpr float QSCALE = 0.08838834764831845f * LOG2E;

constexpr size_t MiB = 1ull << 20;
constexpr size_t WS_CTL = 0, WS_LOGF = 1 * MiB, WS_C2 = 2 * MiB, WS_MA = 3 * MiB, WS_LA = 4 * MiB, WS_SSQ = 5 * MiB, WS_EIDX = 8 * MiB, WS_GATE = 12 * MiB;
constexpr size_t WS_XN = 16 * MiB, WS_QA = 80 * MiB, WS_KA = 116 * MiB, WS_VAN = 152 * MiB, WS_QB = 188 * MiB, WS_KB = 216 * MiB, WS_VBN = 244 * MiB, WS_GA = 272 * MiB, WS_GB = 336 * MiB;
constexpr size_t WS_OA = 400 * MiB, WS_Y = 436 * MiB, WS_MERGED = 476 * MiB, WS_QP = 540 * MiB, WS_UB = 604 * MiB, WS_VB = 732 * MiB;
constexpr size_t WS_WFT = 1020 * MiB, WS_WUT = 1021 * MiB  , WS_WOT = 1041 * MiB, WS_WQT = 1073 * MiB, WS_XN8 = 1089 * MiB  , WS_XS = 1121 * MiB, WS_W8 = 860 * MiB  , WS_WS8 = 1170 * MiB, WS_END = 1171 * MiB;

#define LAS __attribute__((address_space(3)))
typedef unsigned short bf16_t;
__device__ __forceinline__ float bf2f(bf16_t b) { return __uint_as_float(((unsigned)b) << 16); }
__device__ __forceinline__ bf16_t f2bf(float f) { unsigned u = __float_as_uint(f); u += 0x7fffu + ((u >> 16) & 1u); return (bf16_t)(u >> 16); }
__device__ __forceinline__ float wave_sum(float v) {
#pragma unroll
    for (int o = 1; o < 64; o <<= 1) v += __shfl_xor(v, o);
    return v;
}
__device__ __forceinline__ float wave_max(float v) {
#pragma unroll
    for (int o = 1; o < 64; o <<= 1) v = fmaxf(v, __shfl_xor(v, o));
    return v;
}
__device__ __forceinline__ int wave_min_i(int v) {
#pragma unroll
    for (int o = 1; o < 64; o <<= 1) { int t = __shfl_xor(v, o); v = t < v ? t : v; }
    return v;
}
__device__ __forceinline__ int dil_pos(int t, int r) { return (t % r) * (S / r) + t / r; }
__device__ __forceinline__ int group_dil(int g) { return g == 0 ? 1 : (g == 1 ? 4 : 16); }
#define XB_TMO      128
#define XB_XCNT(j)  (256  + 64 * (j))
#define XB_XSUB(j)  (1280 + 64 * (j))
#define XB_XGEN(j)  (2304 + 64 * (j))
#define XB_TOP      3328
#define XB_TOPGEN   3392
#define XCD_BAR_WORDS 3456
#define XB_SPIN_CAP (1u << 18)
#ifndef LAS
#define LAS __attribute__((address_space(3)))
#endif
__device__ __forceinline__ unsigned xb_ld(unsigned* p)              { return __hip_atomic_load(p, __ATOMIC_RELAXED, __HIP_MEMORY_SCOPE_AGENT); }
__device__ __forceinline__ unsigned xb_add(unsigned* p, unsigned v) { return __hip_atomic_fetch_add(p, v, __ATOMIC_RELAXED, __HIP_MEMORY_SCOPE_AGENT); }
__device__ __forceinline__ unsigned xb_xcc_id() { return (unsigned)__builtin_amdgcn_s_getreg((3 << 11) | 20) & 0xFu; }
#define XB_SPIN(cond, bar) do { unsigned _sp = 0; while (cond) { __builtin_amdgcn_s_sleep(1); \
    if ((++_sp & 255u) == 0u) { if (xb_ld(&(bar)[XB_TMO])) break; if (_sp > XB_SPIN_CAP) { atomicAdd(&(bar)[XB_TMO], 1u); break; } } } } while (0)
struct XcdBarrier { unsigned* bar; unsigned x; volatile LAS unsigned* st; };
__device__ __forceinline__ XcdBarrier xcd_barrier_post(unsigned* bar, volatile LAS unsigned* st) {
    XcdBarrier b; b.bar = bar; b.x = xb_xcc_id(); b.st = st;
    if (threadIdx.x == 0) (void)xb_add(&bar[XB_XCNT(b.x)], 1u);
    return b;
}
__device__ __forceinline__ void xcd_barrier_complete(unsigned* bar, unsigned x, unsigned& nloc, unsigned& nx) {
    const unsigned G = gridDim.x * gridDim.y * gridDim.z;
    unsigned sum, cnt, mine, sp = 0u;
    for (;;) {
        sum = 0u; cnt = 0u; mine = 0u;
#pragma unroll
        for (unsigned j = 0; j < 16; ++j) { const unsigned c = xb_ld(&bar[XB_XCNT(j)]); sum += c; cnt += (c > 0u) ? 1u : 0u; mine = (j == x) ? c : mine; }
        if (sum == G) break;
        __builtin_amdgcn_s_sleep(1);
        if ((++sp & 255u) == 0u) { if (xb_ld(&bar[XB_TMO])) break; if (sp > XB_SPIN_CAP) { atomicAdd(&bar[XB_TMO], 1u); break; } }
    }
    nloc = mine > 0u ? mine : 1u; nx = cnt > 0u ? cnt : 1u;
}
__device__ __forceinline__ void xcd_barrier(const XcdBarrier& b) {
    asm volatile("s_waitcnt vmcnt(0)" ::: "memory");
    __syncthreads();
    if (threadIdx.x == 0) {
        unsigned* bar = b.bar;
        __builtin_amdgcn_s_waitcnt(0);
        unsigned nloc = b.st[0], nx = b.st[1];
        if (nloc == 0u) { xcd_barrier_complete(bar, b.x, nloc, nx); b.st[0] = nloc; b.st[1] = nx; }
        const unsigned old = xb_add(&bar[XB_XSUB(b.x)], 1u);
        const unsigned gen = old / nloc;
        if (old + 1u == (gen + 1u) * nloc) {
            __builtin_amdgcn_fence(__ATOMIC_RELEASE, "agent");
            asm volatile("s_waitcnt vmcnt(0)" ::: "memory");
            const unsigned og = xb_add(&bar[XB_TOP], 1u);
            const unsigned tg = og / nx;
            if (og + 1u == (tg + 1u) * nx) xb_add(&bar[XB_TOPGEN], 1u);
            else XB_SPIN(xb_ld(&bar[XB_TOPGEN]) == tg, bar);
            __builtin_amdgcn_fence(__ATOMIC_ACQUIRE, "agent");
            xb_add(&bar[XB_XGEN(b.x)], 1u);
            asm volatile("s_waitcnt vmcnt(0)" ::: "memory");
        } else {
            XB_SPIN(xb_ld(&bar[XB_XGEN(b.x)]) == gen, bar);
            __builtin_amdgcn_fence(__ATOMIC_ACQUIRE, "agent");
            asm volatile("s_waitcnt vmcnt(0)" ::: "memory");
        }
    }
    __syncthreads();
}
namespace pr {
template <int CTRL> __device__ __forceinline__ float dpp_movf(float v) { return __builtin_bit_cast(float, __builtin_amdgcn_update_dpp(0, __builtin_bit_cast(int, v), CTRL, 0xf, 0xf, true)); }
__device__ __forceinline__ float wave_max_u(float v) {
    v = fmaxf(v, dpp_movf<0xB1>(v)); v = fmaxf(v, dpp_movf<0x4E>(v)); v = fmaxf(v, dpp_movf<0x141>(v)); v = fmaxf(v, dpp_movf<0x140>(v));
    const float a = __builtin_bit_cast(float, __builtin_amdgcn_readlane(__builtin_bit_cast(int, v), 0)), b = __builtin_bit_cast(float, __builtin_amdgcn_readlane(__builtin_bit_cast(int, v), 16)),
                c = __builtin_bit_cast(float, __builtin_amdgcn_readlane(__builtin_bit_cast(int, v), 32)), d = __builtin_bit_cast(float, __builtin_amdgcn_readlane(__builtin_bit_cast(int, v), 48));
    return fmaxf(fmaxf(a, b), fmaxf(c, d));
}
__device__ __forceinline__ float rstd_of(const float* __restrict__ ssq, int t, int lane) { return rsqrtf(wave_sum(ssq[t * 64 + lane]) * (1.f / DM) + EPS); }
__device__ __forceinline__ float gelu_erf(float a) { return 0.5f * a * (1.f + erff(a * 0.70710678118654752f)); }
typedef unsigned u32x4g __attribute__((ext_vector_type(4)));
__device__ __forceinline__ float sb2f(unsigned w, int b) { return (float)(signed char)((w >> (8 * b)) & 0xffu); }
__device__ __forceinline__ void gather_token8(int t, int lane, const bf16_t* __restrict__ XN2, const float* __restrict__ ssq, const int* __restrict__ EIDX, const float* __restrict__ GATE,
                                              const unsigned char* __restrict__ U8, const unsigned char* __restrict__ V8, const float* __restrict__ US, const float* __restrict__ VS, float* __restrict__ out) {
    const float rstd = rstd_of(ssq, t, lane);
    unsigned hq[4][4]; float hs;
    { float hv[4][16]; float am = 0.f;
#pragma unroll
      for (int i = 0; i < 4; ++i) { const u32x4g a = *(const u32x4g*)(XN2 + (size_t)t * DM + i * 1024 + lane * 16), b = *(const u32x4g*)(XN2 + (size_t)t * DM + i * 1024 + lane * 16 + 8);
#pragma unroll
          for (int e = 0; e < 4; ++e) { hv[i][2 * e] = __uint_as_float(a[e] << 16); hv[i][2 * e + 1] = __uint_as_float(a[e] & 0xffff0000u); hv[i][8 + 2 * e] = __uint_as_float(b[e] << 16); hv[i][8 + 2 * e + 1] = __uint_as_float(b[e] & 0xffff0000u); }
#pragma unroll
          for (int e = 0; e < 16; ++e) am = fmaxf(am, fabsf(hv[i][e])); }
      am = wave_max_u(am); hs = am * (1.f / 127.f); const float inv = am > 0.f ? 127.f / am : 0.f;
#pragma unroll
      for (int i = 0; i < 4; ++i)
#pragma unroll
          for (int w = 0; w < 4; ++w) { unsigned pk = 0;
#pragma unroll
              for (int b = 0; b < 4; ++b) pk |= ((unsigned)__float2int_rn(hv[i][4 * w + b] * inv) & 0xffu) << (8 * b);
              hq[i][w] = pk; } }
    const int e0 = EIDX[(size_t)t * PK + lane], e1 = EIDX[(size_t)t * PK + 64 + lane];
    const float g0 = GATE[(size_t)t * PK + lane], g1 = GATE[(size_t)t * PK + 64 + lane];
    const float su0 = US[e0], su1 = US[e1], sv0 = VS[e0], sv1 = VS[e1];
    int d0 = 0, d1 = 0;
#pragma unroll 2
    for (int k = 0; k < PK; ++k) {
        const int e = __builtin_amdgcn_readlane(k < 64 ? e0 : e1, k & 63);
        const unsigned char* row = U8 + (size_t)e * DM + lane * 16; int d = 0;
#pragma unroll
        for (int i = 0; i < 4; ++i) { const u32x4g u = *(const u32x4g*)(row + i * 1024);
#pragma unroll
            for (int w = 0; w < 4; ++w) d = __builtin_amdgcn_sdot4((int)u[w], (int)hq[i][w], d, false); }
#pragma unroll
        for (int o = 1; o < 64; o <<= 1) d += __shfl_xor(d, o);
        if (k < 64) d0 = (lane == k) ? d : d0; else d1 = (lane == (k & 63)) ? d : d1;
    }
    const float act0 = gelu_erf((float)d0 * su0 * hs * rstd) * g0 * sv0, act1 = gelu_erf((float)d1 * su1 * hs * rstd) * g1 * sv1;
    float acc[4][16];
#pragma unroll
    for (int i = 0; i < 4; ++i)
#pragma unroll
        for (int j = 0; j < 16; ++j) acc[i][j] = 0.f;
#pragma unroll 2
    for (int k = 0; k < PK; ++k) {
        const int e = __builtin_amdgcn_readlane(k < 64 ? e0 : e1, k & 63);
        const float a = __builtin_bit_cast(float, __builtin_amdgcn_readlane(__builtin_bit_cast(int, k < 64 ? act0 : act1), k & 63));
        const unsigned char* row = V8 + (size_t)e * DM + lane * 16;
#pragma unroll
        for (int i = 0; i < 4; ++i) { const u32x4g u = *(const u32x4g*)(row + i * 1024);
#pragma unroll
            for (int w = 0; w < 4; ++w)
#pragma unroll
                for (int b = 0; b < 4; ++b) acc[i][4 * w + b] += a * sb2f(u[w], b); }
    }
    float* orow = out + (size_t)t * DM + lane * 16;
#pragma unroll
    for (int i = 0; i < 4; ++i)
#pragma unroll
        for (int w = 0; w < 4; ++w) { float4 o = *(float4*)(orow + i * 1024 + 4 * w); o.x += acc[i][4 * w]; o.y += acc[i][4 * w + 1]; o.z += acc[i][4 * w + 2]; o.w += acc[i][4 * w + 3]; *(float4*)(orow + i * 1024 + 4 * w) = o; }
}
__device__ __forceinline__ void phase_gather8(const bf16_t* __restrict__ XN2, const float* __restrict__ ssq, const int* __restrict__ EIDX, const float* __restrict__ GATE,
                                              const unsigned char* __restrict__ U8, const unsigned char* __restrict__ V8, const float* __restrict__ US, const float* __restrict__ VS, float* __restrict__ out, int vcu, int G) {
    const int lane = threadIdx.x & 63, gw = vcu * 8 + (threadIdx.x >> 6), NGW = G * 8;
    for (int t = gw; t < S; t += NGW) gather_token8(t, lane, XN2, ssq, EIDX, GATE, U8, V8, US, VS, out);
}
__device__ __forceinline__ void tq_load(const float* __restrict__ pu, const float* __restrict__ pv, int row, int lane, float4 (&v)[16]) {
    const float* src = (row < NEXP ? pu + (size_t)row * DM : pv + (size_t)(row - NEXP) * DM) + lane * 16;
#pragma unroll
    for (int i = 0; i < 4; ++i)
#pragma unroll
        for (int w = 0; w < 4; ++w) v[4 * i + w] = *(const float4*)(src + i * 1024 + 4 * w);
}
__device__ __forceinline__ void tq_pack(unsigned char* __restrict__ T8, float* __restrict__ TS, int row, int lane, const float4 (&v)[16]) {
    float am = 0.f;
#pragma unroll
    for (int j = 0; j < 16; ++j) am = fmaxf(am, fmaxf(fmaxf(fabsf(v[j].x), fabsf(v[j].y)), fmaxf(fabsf(v[j].z), fabsf(v[j].w))));
    am = wave_max_u(am); const float inv = am > 0.f ? 127.f / am : 0.f;
#pragma unroll
    for (int i = 0; i < 4; ++i) { u32x4g o;
#pragma unroll
        for (int w = 0; w < 4; ++w) { const float4 x = v[4 * i + w]; o[w] = ((unsigned)__float2int_rn(x.x * inv) & 0xffu) | (((unsigned)__float2int_rn(x.y * inv) & 0xffu) << 8) | (((unsigned)__float2int_rn(x.z * inv) & 0xffu) << 16) | (((unsigned)__float2int_rn(x.w * inv) & 0xffu) << 24); }
        *(u32x4g*)(T8 + (size_t)row * DM + i * 1024 + lane * 16) = o; }
    if (lane == 0) TS[row] = am * (1.f / 127.f);
}
__device__ __forceinline__ void quant_tables(const float* __restrict__ pu, const float* __restrict__ pv, unsigned char* __restrict__ T8, float* __restrict__ TS, int gw, int NGW, int lane) {
    float4 va[16], vb[16]; int row = gw;
    if (row < 2 * NEXP) tq_load(pu, pv, row, lane, va);
    while (row < 2 * NEXP) { const int r1 = row + NGW, r2 = r1 + NGW;
        if (r1 < 2 * NEXP) tq_load(pu, pv, r1, lane, vb);
        tq_pack(T8, TS, row, lane, va);
        if (r1 >= 2 * NEXP) break;
        if (r2 < 2 * NEXP) tq_load(pu, pv, r2, lane, va);
        tq_pack(T8, TS, r1, lane, vb);
        row = r2; }
}
template <int CTRL> __device__ __forceinline__ int dpp_movi(int v) { return __builtin_amdgcn_update_dpp(0, v, CTRL, 0xf, 0xf, true); }
__device__ __forceinline__ int wave_sum_i_u(int v) {
    v += dpp_movi<0xB1>(v); v += dpp_movi<0x4E>(v); v += dpp_movi<0x141>(v); v += dpp_movi<0x140>(v);
    return __builtin_amdgcn_readlane(v, 0) + __builtin_amdgcn_readlane(v, 16) + __builtin_amdgcn_readlane(v, 32) + __builtin_amdgcn_readlane(v, 48);
}
__device__ __forceinline__ void quant_tokens(const bf16_t* __restrict__ XN2, unsigned char* __restrict__ H8, float* __restrict__ HS, int gw, int NGW, int lane) {
    u32x4g na_[4], nb_[4];
    if (gw < S) {
#pragma unroll
        for (int i = 0; i < 4; ++i) { na_[i] = *(const u32x4g*)(XN2 + (size_t)gw * DM + i * 1024 + lane * 16); nb_[i] = *(const u32x4g*)(XN2 + (size_t)gw * DM + i * 1024 + lane * 16 + 8); } }
    for (int t = gw; t < S; t += NGW) {
        float hv[4][16]; float am = 0.f;
#pragma unroll
        for (int i = 0; i < 4; ++i) { const u32x4g a = na_[i], b = nb_[i];
#pragma unroll
            for (int e = 0; e < 4; ++e) { hv[i][2 * e] = __uint_as_float(a[e] << 16); hv[i][2 * e + 1] = __uint_as_float(a[e] & 0xffff0000u); hv[i][8 + 2 * e] = __uint_as_float(b[e] << 16); hv[i][8 + 2 * e + 1] = __uint_as_float(b[e] & 0xffff0000u); }
#pragma unroll
            for (int e = 0; e < 16; ++e) am = fmaxf(am, fabsf(hv[i][e])); }
        if (t + NGW < S) {
#pragma unroll
            for (int i = 0; i < 4; ++i) { na_[i] = *(const u32x4g*)(XN2 + (size_t)(t + NGW) * DM + i * 1024 + lane * 16); nb_[i] = *(const u32x4g*)(XN2 + (size_t)(t + NGW) * DM + i * 1024 + lane * 16 + 8); } }
        am = wave_max_u(am); const float inv = am > 0.f ? 127.f / am : 0.f;
#pragma unroll
        for (int i = 0; i < 4; ++i) { u32x4g o;
#pragma unroll
            for (int w = 0; w < 4; ++w) { unsigned pk = 0;
#pragma unroll
                for (int b = 0; b < 4; ++b) pk |= ((unsigned)__float2int_rn(hv[i][4 * w + b] * inv) & 0xffu) << (8 * b);
                o[w] = pk; }
            *(u32x4g*)(H8 + (size_t)t * DM + i * 1024 + lane * 16) = o; }
        if (lane == 0) HS[t] = am * (1.f / 127.f);
    }
}
__device__ __forceinline__ void phase_udot(const unsigned char* __restrict__ H8, const int* __restrict__ EIDX, const unsigned char* __restrict__ U8, int* __restrict__ D, int bx, int G) {
    const int lane = threadIdx.x & 63, w = __builtin_amdgcn_readfirstlane(threadIdx.x >> 6), p = bx & 7, r = bx >> 3, R = G >> 3;
    unsigned hq[8][4][4]; int e0[8], e1[8];
    if (r < S / 64) { const int tb0 = r * 64 + 8 * w;
#pragma unroll
        for (int i = 0; i < 8; ++i) {
#pragma unroll
            for (int j = 0; j < 4; ++j) { const u32x4g v = *(const u32x4g*)(H8 + (size_t)(tb0 + i) * DM + j * 1024 + lane * 16); hq[i][j][0] = v[0]; hq[i][j][1] = v[1]; hq[i][j][2] = v[2]; hq[i][j][3] = v[3]; }
            e0[i] = EIDX[(size_t)(tb0 + i) * PK + lane]; e1[i] = EIDX[(size_t)(tb0 + i) * PK + 64 + lane]; } }
    for (int tg = r; tg < S / 64; tg += R) {
        const int tb = tg * 64 + 8 * w, tbn = (tg + R) * 64 + 8 * w; const bool more = tg + R < S / 64;
#pragma unroll 1
        for (int s = 0; s < 4; ++s) { const int part = p * 4 + s;
#pragma unroll
            for (int i = 0; i < 8; ++i) {
#pragma unroll
                for (int hf = 0; hf < 2; ++hf) { const int ev = hf ? e1[i] : e0[i];
                    unsigned long long bm = __ballot((ev >> 9) == part);
                    while (bm) {
                        const int k0 = __ffsll((long long)bm) - 1; bm &= bm - 1; const bool two = bm != 0ull; const int k1 = two ? __ffsll((long long)bm) - 1 : k0; bm &= bm - 1;
                        const unsigned char* ra = U8 + (size_t)__builtin_amdgcn_readlane(ev, k0) * DM + lane * 16; const unsigned char* rb = U8 + (size_t)__builtin_amdgcn_readlane(ev, k1) * DM + lane * 16;
                        u32x4g ua[4], ub[4];
#pragma unroll
                        for (int j = 0; j < 4; ++j) { ua[j] = *(const u32x4g*)(ra + j * 1024); ub[j] = *(const u32x4g*)(rb + j * 1024); }
                        int da = 0, db = 0;
#pragma unroll
                        for (int j = 0; j < 4; ++j)
#pragma unroll
                            for (int q = 0; q < 4; ++q) { da = __builtin_amdgcn_sdot4((int)ua[j][q], (int)hq[i][j][q], da, false); db = __builtin_amdgcn_sdot4((int)ub[j][q], (int)hq[i][j][q], db, false); }
                        da = wave_sum_i_u(da); db = wave_sum_i_u(db);
                        if (lane == 0) { D[(size_t)(tb + i) * PK + hf * 64 + k0] = da; D[(size_t)(tb + i) * PK + hf * 64 + k1] = db; } } }
                if (s == 3 && more) {
#pragma unroll
                    for (int j = 0; j < 4; ++j) { const u32x4g v = *(const u32x4g*)(H8 + (size_t)(tbn + i) * DM + j * 1024 + lane * 16); hq[i][j][0] = v[0]; hq[i][j][1] = v[1]; hq[i][j][2] = v[2]; hq[i][j][3] = v[3]; }
                    e0[i] = EIDX[(size_t)(tbn + i) * PK + lane]; e1[i] = EIDX[(size_t)(tbn + i) * PK + 64 + lane]; } } }
    }
}
#define VS_TAKE(E, C, HAS) int E = 0, C = 0; bool HAS = false;     \
        if (bm0_) { const int k_ = __ffsll((long long)bm0_) - 1; bm0_ &= bm0_ - 1; const int w_ = __builtin_amdgcn_readlane(E0v_, k_); E = w_ & 0xffff; C = w_ >> 16; HAS = true; } \
        else if (bm1_) { const int k_ = __ffsll((long long)bm1_) - 1; bm1_ &= bm1_ - 1; const int w_ = __builtin_amdgcn_readlane(E1v_, k_); E = w_ & 0xffff; C = w_ >> 16; HAS = true; }
#define VS_MAC4(ACC) _Pragma("unroll") for (int i_ = 0; i_ < 2; ++i_) _Pragma("unroll") for (int w_ = 0; w_ < 4; ++w_) { \
                const unsigned ablo_ = __builtin_amdgcn_perm(xb_[i_][w_], xa_[i_][w_], 0x05010400u), abhi_ = __builtin_amdgcn_perm(xb_[i_][w_], xa_[i_][w_], 0x07030602u); \
                const unsigned cdlo_ = __builtin_amdgcn_perm(xd_[i_][w_], xc_[i_][w_], 0x05010400u), cdhi_ = __builtin_amdgcn_perm(xd_[i_][w_], xc_[i_][w_], 0x07030602u); \
                ACC[i_][4 * w_ + 0] = __builtin_amdgcn_sdot4((int)__builtin_amdgcn_perm(cdlo_, ablo_, 0x05040100u), coef_, ACC[i_][4 * w_ + 0], false); \
                ACC[i_][4 * w_ + 1] = __builtin_amdgcn_sdot4((int)__builtin_amdgcn_perm(cdlo_, ablo_, 0x07060302u), coef_, ACC[i_][4 * w_ + 1], false); \
                ACC[i_][4 * w_ + 2] = __builtin_amdgcn_sdot4((int)__builtin_amdgcn_perm(cdhi_, abhi_, 0x05040100u), coef_, ACC[i_][4 * w_ + 2], false); \
                ACC[i_][4 * w_ + 3] = __builtin_amdgcn_sdot4((int)__builtin_amdgcn_perm(cdhi_, abhi_, 0x07060302u), coef_, ACC[i_][4 * w_ + 3], false); }
#define VS_ROWS4F(ACC, E0, E1, P0, P1) do { const int E0v_ = (E0), E1v_ = (E1); \
          \
        const unsigned long long av0_ = __ballot(((E0v_ >> 10) & 63) <= s) & (P0), av1_ = __ballot(((E1v_ >> 10) & 63) <= s) & (P1); unsigned long long bm0_ = av0_, bm1_ = av1_; \
        for (int nt_ = (__builtin_popcountll(av0_) + __builtin_popcountll(av1_)) >> 2; nt_ > 0; --nt_) { VS_TAKE(ea_, ca_, ha_) VS_TAKE(eb_, cb_, hb_) VS_TAKE(ec_, cc_, hc_) VS_TAKE(ed_, cd_, hd_)     \
            const int coef_ = (ca_ & 255) | ((cb_ & 255) << 8) | ((cc_ & 255) << 16) | (cd_ << 24); \
            u32x4g xa_[2], xb_[2], xc_[2], xd_[2]; \
            { const unsigned char* r_ = vsb + (size_t)ea_ * DM + l16; _Pragma("unroll") for (int i_ = 0; i_ < 2; ++i_) xa_[i_] = *(const u32x4g*)(r_ + i_ * 1024); } \
            { const unsigned char* r_ = vsb + (size_t)eb_ * DM + l16; _Pragma("unroll") for (int i_ = 0; i_ < 2; ++i_) xb_[i_] = *(const u32x4g*)(r_ + i_ * 1024); } \
            { const unsigned char* r_ = vsb + (size_t)ec_ * DM + l16; _Pragma("unroll") for (int i_ = 0; i_ < 2; ++i_) xc_[i_] = *(const u32x4g*)(r_ + i_ * 1024); } \
            { const unsigned char* r_ = vsb + (size_t)ed_ * DM + l16; _Pragma("unroll") for (int i_ = 0; i_ < 2; ++i_) xd_[i_] = *(const u32x4g*)(r_ + i_ * 1024); } \
            VS_MAC4(ACC) } \
        (P0) ^= av0_ ^ bm0_; (P1) ^= av1_ ^ bm1_; } while (0)
#define VS_ROWS4L(ACC, E0, E1, P0, P1) do { const int E0v_ = (E0), E1v_ = (E1);     \
        unsigned long long bm0_ = (P0), bm1_ = (P1); \
        while (bm0_ | bm1_) { VS_TAKE(ea_, ca_, ha_) VS_TAKE(eb_, cb_, hb_) VS_TAKE(ec_, cc_, hc_) VS_TAKE(ed_, cd_, hd_) \
            const int coef_ = (ca_ & 255) | ((cb_ & 255) << 8) | ((cc_ & 255) << 16) | (cd_ << 24); \
            u32x4g xa_[2], xb_[2], xc_[2], xd_[2]; \
            _Pragma("unroll") for (int i_ = 0; i_ < 2; ++i_) { xa_[i_] = (u32x4g){0u, 0u, 0u, 0u}; xb_[i_] = xa_[i_]; xc_[i_] = xa_[i_]; xd_[i_] = xa_[i_]; } \
            { const unsigned char* r_ = vsb + (size_t)ea_ * DM + l16; _Pragma("unroll") for (int i_ = 0; i_ < 2; ++i_) xa_[i_] = *(const u32x4g*)(r_ + i_ * 1024); } \
            if (hb_) { const unsigned char* r_ = vsb + (size_t)eb_ * DM + l16; _Pragma("unroll") for (int i_ = 0; i_ < 2; ++i_) xb_[i_] = *(const u32x4g*)(r_ + i_ * 1024); } \
            if (hc_) { const unsigned char* r_ = vsb + (size_t)ec_ * DM + l16; _Pragma("unroll") for (int i_ = 0; i_ < 2; ++i_) xc_[i_] = *(const u32x4g*)(r_ + i_ * 1024); } \
            if (hd_) { const unsigned char* r_ = vsb + (size_t)ed_ * DM + l16; _Pragma("unroll") for (int i_ = 0; i_ < 2; ++i_) xd_[i_] = *(const u32x4g*)(r_ + i_ * 1024); } \
            VS_MAC4(ACC) } } while (0)
#define VS_TOKEN(X, t) const float rs##X = rstd_of(ssq, t, lane) * HS[t]; const int e##X##0 = EIDX[(size_t)(t) * PK + lane], e##X##1 = EIDX[(size_t)(t) * PK + 64 + lane]; \
        const float a##X##0 = gelu_erf((float)D[(size_t)(t) * PK + lane] * US[e##X##0] * rs##X) * GATE[(size_t)(t) * PK + lane] * VS[e##X##0], a##X##1 = gelu_erf((float)D[(size_t)(t) * PK + 64 + lane] * US[e##X##1] * rs##X) * GATE[(size_t)(t) * PK + 64 + lane] * VS[e##X##1]; \
        const float m##X = wave_max(fmaxf(fabsf(a##X##0), fabsf(a##X##1))); const float i##X = m##X > 0.f ? 127.f / m##X : 0.f; const int c##X##0 = __float2int_rn(a##X##0 * i##X), c##X##1 = __float2int_rn(a##X##1 * i##X);
#define VS_STORE(ACC, X, t) do { const float sc_ = m##X * (1.f / 127.f); float* o_ = out + (size_t)(t) * DM + ph * 2048 + lane * 16; \
        _Pragma("unroll") for (int i_ = 0; i_ < 2; ++i_) _Pragma("unroll") for (int w_ = 0; w_ < 4; ++w_) { float4 q_ = *(float4*)(o_ + i_ * 1024 + 4 * w_); \
            q_.x += sc_ * (float)ACC[i_][4 * w_]; q_.y += sc_ * (float)ACC[i_][4 * w_ + 1]; q_.z += sc_ * (float)ACC[i_][4 * w_ + 2]; q_.w += sc_ * (float)ACC[i_][4 * w_ + 3]; *(float4*)(o_ + i_ * 1024 + 4 * w_) = q_; } } while (0)
__device__ __forceinline__ void phase_vsum2(const int* __restrict__ D, const float* __restrict__ HS, const float* __restrict__ ssq, const int* __restrict__ EIDX, const float* __restrict__ GATE,
                                            const unsigned char* __restrict__ V8, const float* __restrict__ US, const float* __restrict__ VS, float* __restrict__ out, int vcu, int G) {
    const int lane = threadIdx.x & 63, gw = vcu * 8 + __builtin_amdgcn_readfirstlane(threadIdx.x >> 6), NGW = G * 8;
    for (int t0 = 4 * gw; t0 < S; t0 += 4 * NGW) {
        VS_TOKEN(A, t0) VS_TOKEN(B, t0 + 1) VS_TOKEN(C, t0 + 2) VS_TOKEN(E, t0 + 3)
        const int kA0 = eA0 | (cA0 << 16), kA1 = eA1 | (cA1 << 16), kB0 = eB0 | (cB0 << 16), kB1 = eB1 | (cB1 << 16), kC0 = eC0 | (cC0 << 16), kC1 = eC1 | (cC1 << 16), kE0 = eE0 | (cE0 << 16), kE1 = eE1 | (cE1 << 16);
#pragma unroll 1
        for (int ph = 0; ph < 2; ++ph) { const unsigned char* vsb = V8 + ph * 2048; const unsigned l16 = lane * 16;
            int accA[2][16], accB[2][16], accC[2][16], accE[2][16];
#pragma unroll
            for (int i = 0; i < 2; ++i)
#pragma unroll
                for (int j = 0; j < 16; ++j) { accA[i][j] = 0; accB[i][j] = 0; accC[i][j] = 0; accE[i][j] = 0; }
            unsigned long long pA0 = ~0ull, pA1 = ~0ull, pB0 = ~0ull, pB1 = ~0ull, pC0 = ~0ull, pC1 = ~0ull, pE0 = ~0ull, pE1 = ~0ull;
#pragma unroll 1
            for (int s = 0; s < NEXP / 1024 - 1; ++s) { VS_ROWS4F(accA, kA0, kA1, pA0, pA1); VS_ROWS4F(accB, kB0, kB1, pB0, pB1); VS_ROWS4F(accC, kC0, kC1, pC0, pC1); VS_ROWS4F(accE, kE0, kE1, pE0, pE1); }
            VS_ROWS4L(accA, kA0, kA1, pA0, pA1); VS_ROWS4L(accB, kB0, kB1, pB0, pB1); VS_ROWS4L(accC, kC0, kC1, pC0, pC1); VS_ROWS4L(accE, kE0, kE1, pE0, pE1);
            VS_STORE(accA, A, t0); VS_STORE(accB, B, t0 + 1); VS_STORE(accC, C, t0 + 2); VS_STORE(accE, E, t0 + 3);
        }
    }
}
}
namespace pg8 {
#define PG8_LAS __attribute__((address_space(3)))
typedef short bf16x8 __attribute__((ext_vector_type(8)));
typedef float f32x4 __attribute__((ext_vector_type(4)));
typedef unsigned u32x4 __attribute__((ext_vector_type(4)));
typedef unsigned u32x2 __attribute__((ext_vector_type(2)));
#ifndef G1_WGM
#define G1_WGM 8
#endif
constexpr int BM = 256, BK = 64, HALF = 128, HTB = HALF * BK * 2, STAGE_BYTES = 8 * HTB, NXCD = 8, WGM = 8;
__device__ __forceinline__ int lds_byte(int r, int c) { const int st = (r >> 4) * 2 + (c >> 5), rr = r & 15, cc = c & 31, ob = rr * 64 + cc * 2; return st * 1024 + (ob ^ (((ob >> 9) & 1) << 5)); }
__device__ __forceinline__ void stage_rc(int b, int& R, int& C) { const int st = b / 1024, sb = b % 1024, swz = sb ^ (((sb >> 9) & 1) << 5); R = (st >> 1) * 16 + swz / 64; C = (st & 1) * 32 + (swz % 64) / 2; }
__device__ __forceinline__ int perm32(int rho) { const int n = rho >> 4, i = rho & 15; return 8 * (i >> 2) + 4 * n + (i & 3); }
typedef __bf16 bf16x2_t __attribute__((ext_vector_type(2)));
typedef float f32x2_t __attribute__((ext_vector_type(2)));
__device__ __forceinline__ unsigned cvt_pk_bf16(float lo, float hi) { return __builtin_bit_cast(unsigned, __builtin_convertvector((f32x2_t){lo, hi}, bf16x2_t)); }

struct Tile { const char* A; const char* B; int nt, pm, pn, kind, seq; };
template <int WGMT = WGM> __device__ __forceinline__ void static_order(int L, int nM, int nN, int& pm, int& pn) {
    const int nwg = nM * nN; int wgid = L; { const int q = nwg / NXCD, r = nwg % NXCD, xcd = wgid % NXCD, off = wgid / NXCD; wgid = (xcd < r ? xcd * (q + 1) : r * (q + 1) + (xcd - r) * q) + off; }
    const int nig = WGMT * nN, gid = wgid / nig, fm = gid * WGMT, gsz = (nM - fm) < WGMT ? (nM - fm) : WGMT;
    pm = fm + ((wgid % nig) % gsz); pn = (wgid % nig) / gsz;
}
typedef int i32x4 __attribute__((ext_vector_type(4)));
template <bool I8> __device__ __forceinline__ f32x4 mma16(bf16x8 b, bf16x8 a, f32x4 c) {
    if constexpr (I8) return __builtin_bit_cast(f32x4, __builtin_amdgcn_mfma_i32_16x16x64_i8(__builtin_bit_cast(i32x4, b), __builtin_bit_cast(i32x4, a), __builtin_bit_cast(i32x4, c), 0, 0, 0));
    else return __builtin_amdgcn_mfma_f32_16x16x32_bf16(b, a, c, 0, 0, 0);
}
template <class Epi, class Sched, bool I8 = false>
__device__ __forceinline__ void gemm_phase(PG8_LAS unsigned char* lds, const Sched& S, const Epi& E) {
    const int tid = threadIdx.x, wid = __builtin_amdgcn_readfirstlane(tid >> 6), lane = tid & 63, wr = wid >> 2, wc = wid & 3, fr = lane & 15, fq = lane >> 4;
    unsigned voffA[2], voffB[2];
#pragma unroll
    for (int i = 0; i < 2; ++i) { int R, C; stage_rc(tid * 16 + i * 8192, R, C); const int Rb = (R & ~31) + perm32(R & 31); voffA[i] = (unsigned)R * S.pa + C * 2; voffB[i] = (unsigned)Rb * S.pb + C * 2; }
    const size_t kstep = (size_t)(BK * 2);
    const size_t hsA = (size_t)HALF * S.pa, hsB = (size_t)HALF * S.pb;
    const unsigned ldsw = (unsigned)wid * 1024u;
    const int aoff = lds_byte(wr * 64 + fr, fq * 8), boff = lds_byte(wc * 32 + fr, fq * 8);
#define PG8_SA(b, h) (((b) * 2 + (h)) * HTB)
#define PG8_SB(b, h) ((4 + (b) * 2 + (h)) * HTB)
#define PG8_STAGE(bufoff, gbase, voff) do { _Pragma("unroll") for (int _i = 0; _i < 2; ++_i) \
        __builtin_amdgcn_global_load_lds((const unsigned*)((const char*)(gbase) + (voff)[_i]), (PG8_LAS unsigned*)(lds + (bufoff) + ldsw + _i * 8192), 16, 0, 0); } while (0)
#define PG8_LDA(dst, b, h) do { _Pragma("unroll") for (int m = 0; m < 4; ++m) _Pragma("unroll") for (int k = 0; k < 2; ++k) dst[m][k] = *(const PG8_LAS bf16x8*)(lds + PG8_SA(b, h) + aoff + m * 2048 + k * 1024); } while (0)
#define PG8_LDB(dst, b, h) do { _Pragma("unroll") for (int n = 0; n < 2; ++n) _Pragma("unroll") for (int k = 0; k < 2; ++k) dst[n][k] = *(const PG8_LAS bf16x8*)(lds + PG8_SB(b, h) + boff + n * 2048 + k * 1024); } while (0)
#define PG8_MMA(ai, bj, At, Bt) do { __builtin_amdgcn_s_setprio(1); _Pragma("unroll") for (int m = 0; m < 4; ++m) _Pragma("unroll") for (int n = 0; n < 2; ++n) _Pragma("unroll") for (int k = 0; k < 2; ++k) \
        acc[ai][bj][m][n] = mma16<I8>(Bt[n][k], At[m][k], acc[ai][bj][m][n]); __builtin_amdgcn_s_setprio(0); } while (0)
#define PG8_WAIT_V(n) asm volatile("s_waitcnt vmcnt(" #n ")" ::: "memory")
#define PG8_WAIT_L(n) asm volatile("s_waitcnt lgkmcnt(" #n ")" ::: "memory")
#define PG8_BAR __builtin_amdgcn_s_barrier()
#define PG8_SCHED __builtin_amdgcn_sched_barrier(0)
    Tile cur, nxt; int ui = 0;
    if (!S.next(0, cur)) return;
    f32x4 acc[2][2][4][2];
#pragma unroll
    for (int a = 0; a < 2; ++a)
#pragma unroll
        for (int b = 0; b < 2; ++b)
#pragma unroll
            for (int m = 0; m < 4; ++m)
#pragma unroll
                for (int n = 0; n < 2; ++n) acc[a][b][m][n] = (f32x4){0.f, 0.f, 0.f, 0.f};
    bf16x8 At[4][2], B0[2][2], B1[2][2];
    const char* cA = cur.A; const char* cB = cur.B;
    PG8_STAGE(PG8_SB(0, 0), cB, voffB); PG8_STAGE(PG8_SA(0, 0), cA, voffA); PG8_STAGE(PG8_SB(0, 1), cB + hsB, voffB); PG8_STAGE(PG8_SA(0, 1), cA + hsA, voffA);
    if (wr == 1) PG8_BAR;
    PG8_WAIT_V(4); PG8_BAR;
    PG8_STAGE(PG8_SB(1, 0), cB + kstep, voffB); PG8_STAGE(PG8_SA(1, 0), cA + kstep, voffA); PG8_STAGE(PG8_SB(1, 1), cB + hsB + kstep, voffB);
    PG8_WAIT_V(6); PG8_BAR;
    for (;;) {
        const bool has_next = S.next(ui + 1, nxt);
        const char* nA = has_next ? nxt.A : cA; const char* nB = has_next ? nxt.B : cB;
        const int nt = cur.nt;
        for (int t = 0; t < nt; t += 2) {
            const bool last = (t == nt - 2);
            const char* a1 = cA + (size_t)(t + 1) * kstep;
            const char* a2 = last ? nA : cA + (size_t)(t + 2) * kstep; const char* b2 = last ? nB : cB + (size_t)(t + 2) * kstep;
            const char* a3 = a2 + kstep; const char* b3 = b2 + kstep;
            PG8_LDB(B0, 0, 0); PG8_SCHED; PG8_LDA(At, 0, 0); PG8_STAGE(PG8_SA(1, 1), a1 + hsA, voffA);
            PG8_WAIT_L(8); PG8_BAR; PG8_WAIT_L(0); PG8_MMA(0, 0, At, B0); PG8_BAR; PG8_SCHED;
            PG8_LDB(B1, 0, 1); PG8_STAGE(PG8_SB(0, 0), b2, voffB);
            PG8_BAR; PG8_WAIT_L(0); PG8_MMA(0, 1, At, B1); PG8_BAR;
            PG8_LDA(At, 0, 1); PG8_STAGE(PG8_SA(0, 0), a2, voffA);
            PG8_BAR; PG8_WAIT_L(0); PG8_MMA(1, 0, At, B0); PG8_BAR; PG8_SCHED;
            PG8_STAGE(PG8_SB(0, 1), b2 + hsB, voffB);
            PG8_WAIT_V(6); PG8_BAR; PG8_MMA(1, 1, At, B1); PG8_BAR;
            PG8_LDB(B0, 1, 0); PG8_SCHED; PG8_LDA(At, 1, 0); PG8_STAGE(PG8_SA(0, 1), a2 + hsA, voffA);
            PG8_WAIT_L(8); PG8_BAR; PG8_WAIT_L(0); PG8_MMA(0, 0, At, B0); PG8_BAR; PG8_SCHED;
            PG8_LDB(B1, 1, 1); PG8_STAGE(PG8_SB(1, 0), b3, voffB);
            PG8_BAR; PG8_WAIT_L(0); PG8_MMA(0, 1, At, B1); PG8_BAR;
            PG8_LDA(At, 1, 1); PG8_STAGE(PG8_SA(1, 0), a3, voffA);
            PG8_BAR; PG8_WAIT_L(0); PG8_MMA(1, 0, At, B0); PG8_BAR; PG8_SCHED;
            PG8_STAGE(PG8_SB(1, 1), b3 + hsB, voffB);
            PG8_WAIT_V(6); PG8_BAR; PG8_MMA(1, 1, At, B1); PG8_BAR;
        }
        const bool keep = E(acc, cur, wr, wc, fr, fq, lds + STAGE_BYTES);
        if (!has_next) break;
        if (!keep) {
#pragma unroll
            for (int a = 0; a < 2; ++a)
#pragma unroll
                for (int b = 0; b < 2; ++b)
#pragma unroll
                    for (int m = 0; m < 4; ++m)
#pragma unroll
                        for (int n = 0; n < 2; ++n) acc[a][b][m][n] = (f32x4){0.f, 0.f, 0.f, 0.f};
        }
        cur = nxt; cA = nA; cB = nB; ++ui;
    }
    PG8_WAIT_V(0);
    if (wr == 0) PG8_BAR;
    PG8_BAR;
#undef PG8_SA
#undef PG8_SB
#undef PG8_STAGE
#undef PG8_LDA
#undef PG8_LDB
#undef PG8_MMA
}
#define EPI_BAR() do { asm volatile("s_waitcnt lgkmcnt(0)" ::: "memory"); __builtin_amdgcn_s_barrier(); asm volatile("" ::: "memory"); } while (0)

struct Epi1 {
    unsigned char* ws; const float *XS, *WS8; const float *gqa, *gka, *gqb, *gkb;
    __device__ __forceinline__ bool operator()(f32x4 (&acc)[2][2][4][2], const Tile& u, int wr, int wc, int fr, int fq, PG8_LAS unsigned char* scr) const {
        const int pn = u.pn; size_t boff; int W, ct; const float* gain; float sc = 1.f;
        if (pn < 9) { boff = WS_QA; W = WA; ct = pn; gain = gqa; sc = QSCALE; } else if (pn < 18) { boff = WS_KA; W = WA; ct = pn - 9; gain = gka; }
        else if (pn < 25) { boff = WS_QB; W = WB; ct = pn - 18; gain = gqb; sc = QSCALE; } else { boff = WS_KB; W = WB; ct = pn - 25; gain = gkb; }
        bf16_t* const O = (bf16_t*)(ws + boff);
        const int col0 = ct * 256 + 32 * wc + 8 * fq;
        { const float* wsp = WS8 + pn * 256 + 32 * wc + 8 * fq; f32x4 wsc[2][2]; float xs[2][4];
#pragma unroll
          for (int bj = 0; bj < 2; ++bj) { wsc[bj][0] = *(const f32x4*)(wsp + bj * 128); wsc[bj][1] = *(const f32x4*)(wsp + bj * 128 + 4); }
#pragma unroll
          for (int ai = 0; ai < 2; ++ai)
#pragma unroll
              for (int m = 0; m < 4; ++m) xs[ai][m] = XS[u.pm * 256 + ai * 128 + wr * 64 + m * 16 + fr];
#pragma unroll
          for (int ai = 0; ai < 2; ++ai)
#pragma unroll
              for (int m = 0; m < 4; ++m)
#pragma unroll
                  for (int bj = 0; bj < 2; ++bj)
#pragma unroll
                      for (int h = 0; h < 2; ++h) { const i32x4 a = __builtin_bit_cast(i32x4, acc[ai][bj][m][h]);
#pragma unroll
                          for (int e = 0; e < 4; ++e) acc[ai][bj][m][h][e] = (float)a[e] * xs[ai][m] * wsc[bj][h][e]; } }
        PG8_LAS float* P = (PG8_LAS float*)scr;
#pragma unroll
        for (int ai = 0; ai < 2; ++ai)
#pragma unroll
            for (int m = 0; m < 4; ++m)
#pragma unroll
                for (int bj = 0; bj < 2; ++bj) { const f32x4 a = acc[ai][bj][m][0], b = acc[ai][bj][m][1];
                    float s = (a[0] * a[0] + a[1] * a[1]) + (a[2] * a[2] + a[3] * a[3]) + (b[0] * b[0] + b[1] * b[1]) + (b[2] * b[2] + b[3] * b[3]);
                    s += __shfl_xor(s, 16); s += __shfl_xor(s, 32);
                    if (fq == 0) P[((ai * 128 + wr * 64 + m * 16 + fr) * 2 + bj) * 4 + wc] = s; }
        EPI_BAR();
        const f32x4 g0 = *(const f32x4*)(gain + 32 * wc + 8 * fq) * sc, g1 = *(const f32x4*)(gain + 32 * wc + 8 * fq + 4) * sc;
#pragma unroll
        for (int ai = 0; ai < 2; ++ai)
#pragma unroll
            for (int m = 0; m < 4; ++m) { const int r = ai * 128 + wr * 64 + m * 16 + fr; bf16_t* rowp = O + (size_t)(u.pm * 256 + r) * W + col0;
#pragma unroll
                for (int bj = 0; bj < 2; ++bj) { const f32x4 p = *(const PG8_LAS f32x4*)(P + (r * 2 + bj) * 4);
                    const float rstd = rsqrtf(((p[0] + p[1]) + (p[2] + p[3])) * (1.f / HD) + EPS);
                    const f32x4 v0 = acc[ai][bj][m][0] * rstd * g0, v1 = acc[ai][bj][m][1] * rstd * g1;
                    u32x4 w; w.x = cvt_pk_bf16(v0[0], v0[1]); w.y = cvt_pk_bf16(v0[2], v0[3]); w.z = cvt_pk_bf16(v1[0], v1[1]); w.w = cvt_pk_bf16(v1[2], v1[3]);
                    *(u32x4*)(rowp + bj * 128) = w; } }
        return false;
    }
};
struct Sched1 {
    const char* XN; const char* W; int G, c, nN, nt; unsigned pa, pb;
    __device__ __forceinline__ bool next(int i, Tile& u) const {
        const int L = i * G + c; if (L >= 32 * nN) return false;
        int pm, pn; static_order<G1_WGM>(L, 32, nN, pm, pn); u.seq = L;
        u.nt = nt; u.pm = pm; u.pn = pn; u.A = XN + (size_t)pm * 256 * pa; u.B = W + (size_t)pn * 256 * pb;
        u.kind = 0;
        return true;
    }
};
struct EpiGate8 {
    unsigned char* ws; const float *XS, *WS8;
    __device__ __forceinline__ bool operator()(f32x4 (&acc)[2][2][4][2], const Tile& u, int wr, int wc, int fr, int fq, PG8_LAS unsigned char*) const {
        const int pn = u.pn; const bool sig = pn >= 16; int W, ct; size_t boff;
        if (pn < 9) { W = WA * 2; ct = pn; boff = WS_VAN; } else if (pn < 16) { W = WB * 2; ct = pn - 9; boff = WS_VBN; } else if (pn < 32) { W = DM; ct = pn - 16; boff = WS_GA; } else { W = DM; ct = pn - 32; boff = WS_GB; }
        unsigned char* const obase = ws + boff;
        const int col0 = ct * 256 + 32 * wc + 8 * fq; const float* wsp = WS8 + pn * 256 + 32 * wc + 8 * fq; const float fac = sig ? -LOG2E : 1.f; const float lo8 = pn >= 32 ? 1.f : 0.f;
        f32x4 wsc[2][2];
#pragma unroll
        for (int bj = 0; bj < 2; ++bj) { wsc[bj][0] = *(const f32x4*)(wsp + bj * 128) * fac; wsc[bj][1] = *(const f32x4*)(wsp + bj * 128 + 4) * fac; }
        float xsv[2][4];
#pragma unroll
        for (int ai = 0; ai < 2; ++ai)
#pragma unroll
            for (int m = 0; m < 4; ++m) xsv[ai][m] = XS[u.pm * 256 + ai * 128 + wr * 64 + m * 16 + fr];
        asm volatile("" ::: "memory");
#pragma unroll
        for (int ai = 0; ai < 2; ++ai)
#pragma unroll
            for (int m = 0; m < 4; ++m) { const int row = u.pm * 256 + ai * 128 + wr * 64 + m * 16 + fr; const float xs = xsv[ai][m];
#pragma unroll
                for (int bj = 0; bj < 2; ++bj) { const i32x4 a0 = __builtin_bit_cast(i32x4, acc[ai][bj][m][0]), a1 = __builtin_bit_cast(i32x4, acc[ai][bj][m][1]); f32x4 v0, v1;
#pragma unroll
                    for (int e = 0; e < 4; ++e) { v0[e] = (float)a0[e] * xs * wsc[bj][0][e]; v1[e] = (float)a1[e] * xs * wsc[bj][1][e]; }
                    if (sig) { unsigned lo = 0, hi = 0;
#pragma unroll
                        for (int e = 0; e < 4; ++e) { const float s0 = fmaxf(255.f * __builtin_amdgcn_rcpf(1.f + __builtin_amdgcn_exp2f(v0[e])), lo8), s1 = fmaxf(255.f * __builtin_amdgcn_rcpf(1.f + __builtin_amdgcn_exp2f(v1[e])), lo8);
                            lo |= (unsigned)__float2int_rn(s0) << (8 * e); hi |= (unsigned)__float2int_rn(s1) << (8 * e); }
                        *(u32x2*)(obase + (size_t)row * W + col0 + bj * 128) = (u32x2){lo, hi};
                    } else { bf16_t* rowp = (bf16_t*)(obase + (size_t)row * W) + col0;
                        u32x4 w; w.x = cvt_pk_bf16(v0[0], v0[1]); w.y = cvt_pk_bf16(v0[2], v0[3]); w.z = cvt_pk_bf16(v1[0], v1[1]); w.w = cvt_pk_bf16(v1[2], v1[3]);
                        *(u32x4*)(rowp + bj * 128) = w; } } }
        return false;
    }
};
__device__ __forceinline__ float ub2f(unsigned w, int b) { return (float)((w >> (8 * b)) & 255u); }
struct EpiUp {
    const unsigned char *GA, *GB; bf16_t* MG;
    __device__ __forceinline__ bool operator()(f32x4 (&acc)[2][2][4][2], const Tile& u, int wr, int wc, int fr, int fq, PG8_LAS unsigned char*) const {
        const int col0 = u.pn * 256 + 32 * wc + 8 * fq; const size_t ro0 = (size_t)(u.pm * 256 + wr * 64 + fr) * DM + col0;
        if (u.kind == 0) {
#pragma unroll
            for (int ai = 0; ai < 2; ++ai) {
                u32x2 gav[4][2], gbv[4][2];
#pragma unroll
                for (int m = 0; m < 4; ++m)
#pragma unroll
                    for (int bj = 0; bj < 2; ++bj) { gav[m][bj] = *(const u32x2*)(GA + ro0 + (size_t)(ai * 128 + m * 16) * DM + bj * 128); gbv[m][bj] = *(const u32x2*)(GB + ro0 + (size_t)(ai * 128 + m * 16) * DM + bj * 128); }
                asm volatile("" ::: "memory");
#pragma unroll
                for (int m = 0; m < 4; ++m)
#pragma unroll
                    for (int bj = 0; bj < 2; ++bj) { const u32x2 ga = gav[m][bj], gb = gbv[m][bj];
#pragma unroll
                        for (int e = 0; e < 4; ++e) { acc[ai][bj][m][0][e] *= ub2f(ga.x, e) * __builtin_amdgcn_rcpf(ub2f(gb.x, e)); acc[ai][bj][m][1][e] *= ub2f(ga.y, e) * __builtin_amdgcn_rcpf(ub2f(gb.y, e)); } }
            }
            return true;
        }
#pragma unroll
        for (int ai = 0; ai < 2; ++ai) {
            u32x2 gbv[4][2];
#pragma unroll
            for (int m = 0; m < 4; ++m)
#pragma unroll
                for (int bj = 0; bj < 2; ++bj) gbv[m][bj] = *(const u32x2*)(GB + ro0 + (size_t)(ai * 128 + m * 16) * DM + bj * 128);
            asm volatile("" ::: "memory");
#pragma unroll
            for (int m = 0; m < 4; ++m)
#pragma unroll
                for (int bj = 0; bj < 2; ++bj) { const u32x2 gb = gbv[m][bj]; f32x4 t0, t1;
#pragma unroll
                    for (int e = 0; e < 4; ++e) { t0[e] = acc[ai][bj][m][0][e] * (ub2f(gb.x, e) * (1.f / 255.f)); t1[e] = acc[ai][bj][m][1][e] * (ub2f(gb.y, e) * (1.f / 255.f)); }
                    u32x4 w; w.x = cvt_pk_bf16(t0[0], t0[1]); w.y = cvt_pk_bf16(t0[2], t0[3]); w.z = cvt_pk_bf16(t1[0], t1[1]); w.w = cvt_pk_bf16(t1[2], t1[3]);
                    *(u32x4*)(MG + ro0 + (size_t)(ai * 128 + m * 16) * DM + bj * 128) = w; }
            asm volatile("" ::: "memory");
        }
        return false;
    }
};
struct SchedUp {
    const char* Y; const char* WUT; int G, c; unsigned pa, pb;
    __device__ __forceinline__ bool next(int i, Tile& u) const {
        const int L = (i >> 1) * G + c; if (L >= 512) return false;
        int pm, pn; static_order(L, 32, 16, pm, pn); const int seg = i & 1;
        u.pm = pm; u.pn = pn; u.kind = seg; u.nt = seg ? WB / BK : WAO / BK;
        u.A = Y + (size_t)pm * 256 * (YW * 2) + (seg ? WAO * 2 : 0); u.B = WUT + (size_t)pn * 256 * (YW * 2) + (seg ? WAO * 2 : 0);
        return true;
    }
};
struct EpiOut {
    const float *x, *g2; float* H; bf16_t* XN2; float* SSQ;
    __device__ __forceinline__ bool operator()(f32x4 (&acc)[2][2][4][2], const Tile& u, int wr, int wc, int fr, int fq, PG8_LAS unsigned char*) const {
        const int col0 = u.pn * 256 + 32 * wc + 8 * fq;
        f32x4 gg[2][2];
#pragma unroll
        for (int bj = 0; bj < 2; ++bj) { gg[bj][0] = *(const f32x4*)(g2 + col0 + bj * 128); gg[bj][1] = *(const f32x4*)(g2 + col0 + bj * 128 + 4); }
#pragma unroll
        for (int ai = 0; ai < 2; ++ai)
#pragma unroll
        for (int mh = 0; mh < 2; ++mh) {
            f32x4 xv[2][2][2];
#pragma unroll
            for (int m2 = 0; m2 < 2; ++m2)
#pragma unroll
                for (int bj = 0; bj < 2; ++bj) { const size_t ro = (size_t)(u.pm * 256 + ai * 128 + wr * 64 + (mh * 2 + m2) * 16 + fr) * DM + col0 + bj * 128; xv[m2][bj][0] = *(const f32x4*)(x + ro); xv[m2][bj][1] = *(const f32x4*)(x + ro + 4); }
            asm volatile("" ::: "memory");
#pragma unroll
            for (int m2 = 0; m2 < 2; ++m2) { const int m = mh * 2 + m2; const int row = u.pm * 256 + ai * 128 + wr * 64 + m * 16 + fr; const size_t ro = (size_t)row * DM + col0; float ss = 0.f;
#pragma unroll
                for (int bj = 0; bj < 2; ++bj) { const f32x4 h0 = xv[m2][bj][0] + acc[ai][bj][m][0], h1 = xv[m2][bj][1] + acc[ai][bj][m][1];
                    *(f32x4*)(H + ro + bj * 128) = h0; *(f32x4*)(H + ro + bj * 128 + 4) = h1;
                    ss += (h0[0] * h0[0] + h0[1] * h0[1]) + (h0[2] * h0[2] + h0[3] * h0[3]) + (h1[0] * h1[0] + h1[1] * h1[1]) + (h1[2] * h1[2] + h1[3] * h1[3]);
                    const f32x4 a = h0 * gg[bj][0], b = h1 * gg[bj][1];
                    u32x4 w; w.x = cvt_pk_bf16(a[0], a[1]); w.y = cvt_pk_bf16(a[2], a[3]); w.z = cvt_pk_bf16(b[0], b[1]); w.w = cvt_pk_bf16(b[2], b[3]);
                    *(u32x4*)(XN2 + ro + bj * 128) = w; }
                ss += __shfl_xor(ss, 16); ss += __shfl_xor(ss, 32);
                if (fq == 0) SSQ[row * 64 + u.pn * 4 + wc] = ss; }
            asm volatile("" ::: "memory");
        }
        return false;
    }
};
struct EpiHiLo {
    bf16_t *H, *L; int ldc, pad;
    __device__ __forceinline__ bool operator()(f32x4 (&acc)[2][2][4][2], const Tile& u, int wr, int wc, int fr, int fq, PG8_LAS unsigned char*) const {
        const int col0 = u.pn * 256 + 32 * wc + 8 * fq;
#pragma unroll
        for (int ai = 0; ai < 2; ++ai)
#pragma unroll
            for (int m = 0; m < 4; ++m) { const size_t ro = (size_t)(u.pm * 256 + ai * 128 + wr * 64 + m * 16 + fr) * ldc + col0;
#pragma unroll
                for (int bj = 0; bj < 2; ++bj) { u32x4 wh, wl;
#pragma unroll
                    for (int e = 0; e < 4; ++e) { const float a = acc[ai][bj][m][e >> 1][2 * (e & 1)], b = acc[ai][bj][m][e >> 1][2 * (e & 1) + 1];
                        const unsigned hp = cvt_pk_bf16(a, b); wh[e] = hp; wl[e] = cvt_pk_bf16(a - __uint_as_float(hp << 16), b - __uint_as_float(hp & 0xffff0000u)); }
                    *(u32x4*)(H + ro + bj * 128) = wh; *(u32x4*)(L + ro + bj * 128) = wl; } }
        return false;
    }
};
struct EpiNull { int kp, pad; __device__ __forceinline__ bool operator()(f32x4 (&acc)[2][2][4][2], const Tile& u, int, int, int, int, PG8_LAS unsigned char*) const {
        float s = 0.f;
#pragma unroll
        for (int a = 0; a < 2; ++a)
#pragma unroll
            for (int b = 0; b < 2; ++b)
#pragma unroll
                for (int m = 0; m < 4; ++m)
#pragma unroll
                    for (int n = 0; n < 2; ++n) s += acc[a][b][m][n][0] + acc[a][b][m][n][1] + acc[a][b][m][n][2] + acc[a][b][m][n][3];
        if (s == 1.2345e33f) *(float*)u.A = s;
        return kp && u.kind == 0; } };
struct SchedPlain {
    const char* A; const char* B; int G, c, nM, nN, K; unsigned pa, pb;
    __device__ __forceinline__ bool next(int i, Tile& u) const {
        const int L = i * G + c; if (L >= nM * nN) return false;
        int pm, pn; static_order(L, nM, nN, pm, pn);
        u.pm = pm; u.pn = pn; u.kind = 0; u.nt = K / BK; u.A = A + (size_t)pm * 256 * pa; u.B = B + (size_t)pn * 256 * pb;
        return true;
    }
};
}
namespace tk {
typedef short bf16x8 __attribute__((ext_vector_type(8)));
typedef float f32x16 __attribute__((ext_vector_type(16)));
typedef float f32x4 __attribute__((ext_vector_type(4)));
typedef unsigned u32x4 __attribute__((ext_vector_type(4)));
__device__ __forceinline__ unsigned f2key(float f) { const unsigned b = __float_as_uint(f); return b ^ ((unsigned)((int)b >> 31) | 0x80000000u); }
__device__ __forceinline__ float key2f(unsigned u) { return __uint_as_float(u ^ (~(unsigned)((int)u >> 31) | 0x80000000u)); }
__device__ __forceinline__ unsigned umax(unsigned a, unsigned b) { return a > b ? a : b; }
__device__ __forceinline__ unsigned umin(unsigned a, unsigned b) { return a < b ? a : b; }
#define TK_CE(x, y) do { const unsigned lo_ = umin(x, y), hi_ = umax(x, y); x = hi_; y = lo_; } while (0)
__device__ __forceinline__ void sort16_desc(unsigned (&a)[16]) {
    TK_CE(a[0], a[1]);
    TK_CE(a[3], a[2]);
    TK_CE(a[4], a[5]);
    TK_CE(a[7], a[6]);
    TK_CE(a[8], a[9]);
    TK_CE(a[11], a[10]);
    TK_CE(a[12], a[13]);
    TK_CE(a[15], a[14]);
    TK_CE(a[0], a[2]);
    TK_CE(a[1], a[3]);
    TK_CE(a[6], a[4]);
    TK_CE(a[7], a[5]);
    TK_CE(a[8], a[10]);
    TK_CE(a[9], a[11]);
    TK_CE(a[14], a[12]);
    TK_CE(a[15], a[13]);
    TK_CE(a[0], a[1]);
    TK_CE(a[2], a[3]);
    TK_CE(a[5], a[4]);
    TK_CE(a[7], a[6]);
    TK_CE(a[8], a[9]);
    TK_CE(a[10], a[11]);
    TK_CE(a[13], a[12]);
    TK_CE(a[15], a[14]);
    TK_CE(a[0], a[4]);
    TK_CE(a[1], a[5]);
    TK_CE(a[2], a[6]);
    TK_CE(a[3], a[7]);
    TK_CE(a[12], a[8]);
    TK_CE(a[13], a[9]);
    TK_CE(a[14], a[10]);
    TK_CE(a[15], a[11]);
    TK_CE(a[0], a[2]);
    TK_CE(a[1], a[3]);
    TK_CE(a[4], a[6]);
    TK_CE(a[5], a[7]);
    TK_CE(a[10], a[8]);
    TK_CE(a[11], a[9]);
    TK_CE(a[14], a[12]);
    TK_CE(a[15], a[13]);
    TK_CE(a[0], a[1]);
    TK_CE(a[2], a[3]);
    TK_CE(a[4], a[5]);
    TK_CE(a[6], a[7]);
    TK_CE(a[9], a[8]);
    TK_CE(a[11], a[10]);
    TK_CE(a[13], a[12]);
    TK_CE(a[15], a[14]);
    TK_CE(a[0], a[8]);
    TK_CE(a[1], a[9]);
    TK_CE(a[2], a[10]);
    TK_CE(a[3], a[11]);
    TK_CE(a[4], a[12]);
    TK_CE(a[5], a[13]);
    TK_CE(a[6], a[14]);
    TK_CE(a[7], a[15]);
    TK_CE(a[0], a[4]);
    TK_CE(a[1], a[5]);
    TK_CE(a[2], a[6]);
    TK_CE(a[3], a[7]);
    TK_CE(a[8], a[12]);
    TK_CE(a[9], a[13]);
    TK_CE(a[10], a[14]);
    TK_CE(a[11], a[15]);
    TK_CE(a[0], a[2]);
    TK_CE(a[1], a[3]);
    TK_CE(a[4], a[6]);
    TK_CE(a[5], a[7]);
    TK_CE(a[8], a[10]);
    TK_CE(a[9], a[11]);
    TK_CE(a[12], a[14]);
    TK_CE(a[13], a[15]);
    TK_CE(a[0], a[1]);
    TK_CE(a[2], a[3]);
    TK_CE(a[4], a[5]);
    TK_CE(a[6], a[7]);
    TK_CE(a[8], a[9]);
    TK_CE(a[10], a[11]);
    TK_CE(a[12], a[13]);
    TK_CE(a[14], a[15]);
}
__device__ __forceinline__ void merge_top16(unsigned (&a)[16], const unsigned (&b)[16]) {
    a[0] = umax(a[0], b[15]);
    a[1] = umax(a[1], b[14]);
    a[2] = umax(a[2], b[13]);
    a[3] = umax(a[3], b[12]);
    a[4] = umax(a[4], b[11]);
    a[5] = umax(a[5], b[10]);
    a[6] = umax(a[6], b[9]);
    a[7] = umax(a[7], b[8]);
    a[8] = umax(a[8], b[7]);
    a[9] = umax(a[9], b[6]);
    a[10] = umax(a[10], b[5]);
    a[11] = umax(a[11], b[4]);
    a[12] = umax(a[12], b[3]);
    a[13] = umax(a[13], b[2]);
    a[14] = umax(a[14], b[1]);
    a[15] = umax(a[15], b[0]);
    TK_CE(a[0], a[8]);
    TK_CE(a[1], a[9]);
    TK_CE(a[2], a[10]);
    TK_CE(a[3], a[11]);
    TK_CE(a[4], a[12]);
    TK_CE(a[5], a[13]);
    TK_CE(a[6], a[14]);
    TK_CE(a[7], a[15]);
    TK_CE(a[0], a[4]);
    TK_CE(a[1], a[5]);
    TK_CE(a[2], a[6]);
    TK_CE(a[3], a[7]);
    TK_CE(a[8], a[12]);
    TK_CE(a[9], a[13]);
    TK_CE(a[10], a[14]);
    TK_CE(a[11], a[15]);
    TK_CE(a[0], a[2]);
    TK_CE(a[1], a[3]);
    TK_CE(a[4], a[6]);
    TK_CE(a[5], a[7]);
    TK_CE(a[8], a[10]);
    TK_CE(a[9], a[11]);
    TK_CE(a[12], a[14]);
    TK_CE(a[13], a[15]);
    TK_CE(a[0], a[1]);
    TK_CE(a[2], a[3]);
    TK_CE(a[4], a[5]);
    TK_CE(a[6], a[7]);
    TK_CE(a[8], a[9]);
    TK_CE(a[10], a[11]);
    TK_CE(a[12], a[13]);
    TK_CE(a[14], a[15]);
}
#define TK_CE2(i, l) do { const bool sw_ = k[i] < k[l]; const unsigned k0_ = sw_ ? k[l] : k[i], k1_ = sw_ ? k[i] : k[l], p0_ = sw_ ? p[l] : p[i], p1_ = sw_ ? p[i] : p[l]; k[i] = k0_; k[l] = k1_; p[i] = p0_; p[l] = p1_; } while (0)
__device__ __forceinline__ void sort16_desc2(unsigned (&k)[16], unsigned (&p)[16]) {
    TK_CE2(0, 1);
    TK_CE2(3, 2);
    TK_CE2(4, 5);
    TK_CE2(7, 6);
    TK_CE2(8, 9);
    TK_CE2(11, 10);
    TK_CE2(12, 13);
    TK_CE2(15, 14);
    TK_CE2(0, 2);
    TK_CE2(1, 3);
    TK_CE2(6, 4);
    TK_CE2(7, 5);
    TK_CE2(8, 10);
    TK_CE2(9, 11);
    TK_CE2(14, 12);
    TK_CE2(15, 13);
    TK_CE2(0, 1);
    TK_CE2(2, 3);
    TK_CE2(5, 4);
    TK_CE2(7, 6);
    TK_CE2(8, 9);
    TK_CE2(10, 11);
    TK_CE2(13, 12);
    TK_CE2(15, 14);
    TK_CE2(0, 4);
    TK_CE2(1, 5);
    TK_CE2(2, 6);
    TK_CE2(3, 7);
    TK_CE2(12, 8);
    TK_CE2(13, 9);
    TK_CE2(14, 10);
    TK_CE2(15, 11);
    TK_CE2(0, 2);
    TK_CE2(1, 3);
    TK_CE2(4, 6);
    TK_CE2(5, 7);
    TK_CE2(10, 8);
    TK_CE2(11, 9);
    TK_CE2(14, 12);
    TK_CE2(15, 13);
    TK_CE2(0, 1);
    TK_CE2(2, 3);
    TK_CE2(4, 5);
    TK_CE2(6, 7);
    TK_CE2(9, 8);
    TK_CE2(11, 10);
    TK_CE2(13, 12);
    TK_CE2(15, 14);
    TK_CE2(0, 8);
    TK_CE2(1, 9);
    TK_CE2(2, 10);
    TK_CE2(3, 11);
    TK_CE2(4, 12);
    TK_CE2(5, 13);
    TK_CE2(6, 14);
    TK_CE2(7, 15);
    TK_CE2(0, 4);
    TK_CE2(1, 5);
    TK_CE2(2, 6);
    TK_CE2(3, 7);
    TK_CE2(8, 12);
    TK_CE2(9, 13);
    TK_CE2(10, 14);
    TK_CE2(11, 15);
    TK_CE2(0, 2);
    TK_CE2(1, 3);
    TK_CE2(4, 6);
    TK_CE2(5, 7);
    TK_CE2(8, 10);
    TK_CE2(9, 11);
    TK_CE2(12, 14);
    TK_CE2(13, 15);
    TK_CE2(0, 1);
    TK_CE2(2, 3);
    TK_CE2(4, 5);
    TK_CE2(6, 7);
    TK_CE2(8, 9);
    TK_CE2(10, 11);
    TK_CE2(12, 13);
    TK_CE2(14, 15);
}
__device__ __forceinline__ void merge_top16_2(unsigned (&k)[16], unsigned (&p)[16], const unsigned (&kb)[16], const unsigned (&pb)[16]) {
    { const bool t_ = kb[15] > k[0]; k[0] = t_ ? kb[15] : k[0]; p[0] = t_ ? pb[15] : p[0]; }
    { const bool t_ = kb[14] > k[1]; k[1] = t_ ? kb[14] : k[1]; p[1] = t_ ? pb[14] : p[1]; }
    { const bool t_ = kb[13] > k[2]; k[2] = t_ ? kb[13] : k[2]; p[2] = t_ ? pb[13] : p[2]; }
    { const bool t_ = kb[12] > k[3]; k[3] = t_ ? kb[12] : k[3]; p[3] = t_ ? pb[12] : p[3]; }
    { const bool t_ = kb[11] > k[4]; k[4] = t_ ? kb[11] : k[4]; p[4] = t_ ? pb[11] : p[4]; }
    { const bool t_ = kb[10] > k[5]; k[5] = t_ ? kb[10] : k[5]; p[5] = t_ ? pb[10] : p[5]; }
    { const bool t_ = kb[9] > k[6]; k[6] = t_ ? kb[9] : k[6]; p[6] = t_ ? pb[9] : p[6]; }
    { const bool t_ = kb[8] > k[7]; k[7] = t_ ? kb[8] : k[7]; p[7] = t_ ? pb[8] : p[7]; }
    { const bool t_ = kb[7] > k[8]; k[8] = t_ ? kb[7] : k[8]; p[8] = t_ ? pb[7] : p[8]; }
    { const bool t_ = kb[6] > k[9]; k[9] = t_ ? kb[6] : k[9]; p[9] = t_ ? pb[6] : p[9]; }
    { const bool t_ = kb[5] > k[10]; k[10] = t_ ? kb[5] : k[10]; p[10] = t_ ? pb[5] : p[10]; }
    { const bool t_ = kb[4] > k[11]; k[11] = t_ ? kb[4] : k[11]; p[11] = t_ ? pb[4] : p[11]; }
    { const bool t_ = kb[3] > k[12]; k[12] = t_ ? kb[3] : k[12]; p[12] = t_ ? pb[3] : p[12]; }
    { const bool t_ = kb[2] > k[13]; k[13] = t_ ? kb[2] : k[13]; p[13] = t_ ? pb[2] : p[13]; }
    { const bool t_ = kb[1] > k[14]; k[14] = t_ ? kb[1] : k[14]; p[14] = t_ ? pb[1] : p[14]; }
    { const bool t_ = kb[0] > k[15]; k[15] = t_ ? kb[0] : k[15]; p[15] = t_ ? pb[0] : p[15]; }
    TK_CE2(0, 8);
    TK_CE2(1, 9);
    TK_CE2(2, 10);
    TK_CE2(3, 11);
    TK_CE2(4, 12);
    TK_CE2(5, 13);
    TK_CE2(6, 14);
    TK_CE2(7, 15);
    TK_CE2(0, 4);
    TK_CE2(1, 5);
    TK_CE2(2, 6);
    TK_CE2(3, 7);
    TK_CE2(8, 12);
    TK_CE2(9, 13);
    TK_CE2(10, 14);
    TK_CE2(11, 15);
    TK_CE2(0, 2);
    TK_CE2(1, 3);
    TK_CE2(4, 6);
    TK_CE2(5, 7);
    TK_CE2(8, 10);
    TK_CE2(9, 11);
    TK_CE2(12, 14);
    TK_CE2(13, 15);
    TK_CE2(0, 1);
    TK_CE2(2, 3);
    TK_CE2(4, 5);
    TK_CE2(6, 7);
    TK_CE2(8, 9);
    TK_CE2(10, 11);
    TK_CE2(12, 13);
    TK_CE2(14, 15);
}
#define TK_CAND(slot, who, a, b) do { const unsigned kx_ = f2key(f1[a] + f2[b]), px_ = ((t0[a] & 127u) << 7) | (t1[b] & 127u); \
    if (who == 0) { ck[slot] = hh ? ck[slot] : kx_; cp[slot] = hh ? cp[slot] : px_; } else { ck[slot] = hh ? kx_ : ck[slot]; cp[slot] = hh ? px_ : cp[slot]; } } while (0)
__device__ __forceinline__ void make_cands(const unsigned (&t0)[16], const unsigned (&t1)[16], const float (&f1)[16], const float (&f2)[16], int hh, unsigned (&ck)[32], unsigned (&cp)[32]) {
    TK_CAND(0, 0, 0, 0);
    TK_CAND(0, 1, 0, 1);
    TK_CAND(1, 0, 0, 2);
    TK_CAND(1, 1, 0, 3);
    TK_CAND(2, 0, 0, 4);
    TK_CAND(2, 1, 0, 5);
    TK_CAND(3, 0, 0, 6);
    TK_CAND(3, 1, 0, 7);
    TK_CAND(4, 0, 0, 8);
    TK_CAND(4, 1, 0, 9);
    TK_CAND(5, 0, 0, 10);
    TK_CAND(5, 1, 0, 11);
    TK_CAND(6, 0, 0, 12);
    TK_CAND(6, 1, 0, 13);
    TK_CAND(7, 0, 0, 14);
    TK_CAND(7, 1, 0, 15);
    TK_CAND(8, 0, 1, 0);
    TK_CAND(8, 1, 1, 1);
    TK_CAND(9, 0, 1, 2);
    TK_CAND(9, 1, 1, 3);
    TK_CAND(10, 0, 1, 4);
    TK_CAND(10, 1, 1, 5);
    TK_CAND(11, 0, 1, 6);
    TK_CAND(11, 1, 1, 7);
    TK_CAND(12, 0, 2, 0);
    TK_CAND(12, 1, 2, 1);
    TK_CAND(13, 0, 2, 2);
    TK_CAND(13, 1, 2, 3);
    TK_CAND(14, 0, 2, 4);
    TK_CAND(14, 1, 3, 0);
    TK_CAND(15, 0, 3, 1);
    TK_CAND(15, 1, 3, 2);
    TK_CAND(16, 0, 3, 3);
    TK_CAND(16, 1, 4, 0);
    TK_CAND(17, 0, 4, 1);
    TK_CAND(17, 1, 4, 2);
    TK_CAND(18, 0, 5, 0);
    TK_CAND(18, 1, 5, 1);
    TK_CAND(19, 0, 6, 0);
    TK_CAND(19, 1, 6, 1);
    TK_CAND(20, 0, 7, 0);
    TK_CAND(20, 1, 7, 1);
    TK_CAND(21, 0, 8, 0);
    TK_CAND(21, 1, 9, 0);
    TK_CAND(22, 0, 10, 0);
    TK_CAND(22, 1, 11, 0);
    TK_CAND(23, 0, 12, 0);
    TK_CAND(23, 1, 13, 0);
    TK_CAND(24, 0, 14, 0);
    TK_CAND(24, 1, 15, 0);
}
__device__ __forceinline__ void score_group(const char* kh, const char* kl, unsigned kvo, const bf16x8 (&qh)[8], const bf16x8 (&ql)[8], int ng, int hh, unsigned (&key)[16]) {
    f32x16 sacc;
#pragma unroll
    for (int r = 0; r < 16; ++r) sacc[r] = 0.f;
#pragma unroll
    for (int ks = 0; ks < 8; ++ks) { const bf16x8 ah = *(const bf16x8*)(kh + 32 * ks + kvo), al = *(const bf16x8*)(kl + 32 * ks + kvo);
        sacc = __builtin_amdgcn_mfma_f32_32x32x16_bf16(ah, qh[ks], sacc, 0, 0, 0); sacc = __builtin_amdgcn_mfma_f32_32x32x16_bf16(ah, ql[ks], sacc, 0, 0, 0); sacc = __builtin_amdgcn_mfma_f32_32x32x16_bf16(al, qh[ks], sacc, 0, 0, 0); }
#pragma unroll
    for (int r = 0; r < 16; ++r) key[r] = (f2key(sacc[r]) & ~127u) | (unsigned)(32 * ng + (r & 3) + 8 * (r >> 2) + 4 * hh);
    sort16_desc(key);
    asm volatile("" ::: "memory");
}
__device__ __forceinline__ void select_half(const bf16_t* __restrict__ QH, const bf16_t* __restrict__ QL, const bf16_t* __restrict__ SKH, const bf16_t* __restrict__ SKL, int t0, int h, int c, int tok, int hh, unsigned (&out)[16]) {
    bf16x8 qh[8], ql[8];
    { const char* qr = (const char*)(QH + (size_t)t0 * PQW + h * PQD + c * PQH); const char* qs = (const char*)(QL + (size_t)t0 * PQW + h * PQD + c * PQH); const unsigned qvo = (unsigned)(tok * PQW + 8 * hh) * 2u;
#pragma unroll
      for (int ks = 0; ks < 8; ++ks) { qh[ks] = *(const bf16x8*)(qr + 32 * ks + qvo); ql[ks] = *(const bf16x8*)(qs + 32 * ks + qvo); } }
    const char* kh = (const char*)(SKH + (size_t)(h * 2 + c) * NKEYS * PQH); const char* kl = (const char*)(SKL + (size_t)(h * 2 + c) * NKEYS * PQH); const unsigned kvo = (unsigned)(tok * PQH + 8 * hh) * 2u;
    unsigned k1[16], k2[16], k3[16];
    score_group(kh, kl, kvo, qh, ql, 0, hh, out);
    score_group(kh + 32 * PQH * 2, kl + 32 * PQH * 2, kvo, qh, ql, 1, hh, k1);
    merge_top16(out, k1);
    score_group(kh + 64 * PQH * 2, kl + 64 * PQH * 2, kvo, qh, ql, 2, hh, k2);
    score_group(kh + 96 * PQH * 2, kl + 96 * PQH * 2, kvo, qh, ql, 3, hh, k3);
    merge_top16(k2, k3); merge_top16(out, k2);
#pragma unroll
    for (int i = 0; i < 16; ++i) k1[i] = (unsigned)__shfl_xor((int)out[i], 32);
    merge_top16(out, k1);
}
__device__ __forceinline__ void topk_item(const bf16_t* __restrict__ QH, const bf16_t* __restrict__ QL, const bf16_t* __restrict__ SKH, const bf16_t* __restrict__ SKL, const float* __restrict__ ssq,
                                          int* __restrict__ EIDX, float* __restrict__ GATE, int h, int t0, int tok, int hh) {
        const int t = t0 + tok;
        unsigned top0[16], top1[16];
        select_half(QH, QL, SKH, SKL, t0, h, 0, tok, hh, top0);
        asm volatile("" ::: "memory");
        select_half(QH, QL, SKH, SKL, t0, h, 1, tok, hh, top1);
        float f1[16], f2[16];
#pragma unroll
        for (int i = 0; i < 16; ++i) { f1[i] = key2f(top0[i]); f2[i] = key2f(top1[i]); }
        unsigned ck32[32], cp32[32];
#pragma unroll
        for (int i = 0; i < 32; ++i) { ck32[i] = 0u; cp32[i] = 0u; }
        make_cands(top0, top1, f1, f2, hh, ck32, cp32);
        unsigned ck[2][16], cp[2][16];
#pragma unroll
        for (int i = 0; i < 16; ++i) { ck[0][i] = ck32[i]; cp[0][i] = cp32[i]; ck[1][i] = ck32[16 + i]; cp[1][i] = cp32[16 + i]; }
        sort16_desc2(ck[0], cp[0]); sort16_desc2(ck[1], cp[1]); merge_top16_2(ck[0], cp[0], ck[1], cp[1]);
        unsigned pk[16], pp[16];
#pragma unroll
        for (int i = 0; i < 16; ++i) { pk[i] = (unsigned)__shfl_xor((int)ck[0][i], 32); pp[i] = (unsigned)__shfl_xor((int)cp[0][i], 32); }
        merge_top16_2(ck[0], cp[0], pk, pp);
        float ss = 0.f; { const f32x4* sp = (const f32x4*)(ssq + (size_t)t * 64);
#pragma unroll
            for (int i = 0; i < 16; ++i) { const f32x4 v = sp[i]; ss += (v[0] + v[1]) + (v[2] + v[3]); } }
        const float rstd = rsqrtf(ss * (1.f / DM) + EPS);
        float ez[16]; float den = 0.f; const float z0 = key2f(ck[0][0]);
#pragma unroll
        for (int i = 0; i < 16; ++i) { ez[i] = __expf((key2f(ck[0][i]) - z0) * rstd); den += ez[i]; }
        const float inv = 1.f / den;
        int* ep = EIDX + (size_t)t * PK + h * TOPK; float* gp = GATE + (size_t)t * PK + h * TOPK;
        if (hh == 0) {
            *(u32x4*)(ep) = (u32x4){cp[0][0], cp[0][1], cp[0][2], cp[0][3]}; *(u32x4*)(ep + 4) = (u32x4){cp[0][4], cp[0][5], cp[0][6], cp[0][7]};
            *(f32x4*)(gp) = (f32x4){ez[0] * inv, ez[1] * inv, ez[2] * inv, ez[3] * inv}; *(f32x4*)(gp + 4) = (f32x4){ez[4] * inv, ez[5] * inv, ez[6] * inv, ez[7] * inv};
        } else {
            *(u32x4*)(ep + 8) = (u32x4){cp[0][8], cp[0][9], cp[0][10], cp[0][11]}; *(u32x4*)(ep + 12) = (u32x4){cp[0][12], cp[0][13], cp[0][14], cp[0][15]};
            *(f32x4*)(gp + 8) = (f32x4){ez[8] * inv, ez[9] * inv, ez[10] * inv, ez[11] * inv}; *(f32x4*)(gp + 12) = (f32x4){ez[12] * inv, ez[13] * inv, ez[14] * inv, ez[15] * inv};
        }
}
__device__ __forceinline__ void phase_topk2(const bf16_t* __restrict__ QH, const bf16_t* __restrict__ QL, const bf16_t* __restrict__ SKH, const bf16_t* __restrict__ SKL, const float* __restrict__ ssq,
                                            int* __restrict__ EIDX, float* __restrict__ GATE, int vcu, int G) {
    const int lane = threadIdx.x & 63, tok = lane & 31, hh = lane >> 5, gw = vcu * 8 + __builtin_amdgcn_readfirstlane(threadIdx.x >> 6), NGW = G * 8;
    for (int it = gw; it < PH * (S / 32); it += NGW) {
        int h = it & 7; asm volatile("" : "+s"(h));
        topk_item(QH, QL, SKH, SKL, ssq, EIDX, GATE, h, (it >> 3) * 32, tok, hh);
    }
}
template <class Sched>
__device__ __forceinline__ void phase_topk2_tiles(const bf16_t* __restrict__ QH, const bf16_t* __restrict__ QL, const bf16_t* __restrict__ SKH, const bf16_t* __restrict__ SKL, const float* __restrict__ ssq,
                                                  int* __restrict__ EIDX, float* __restrict__ GATE, const Sched& Sc) {
    const int lane = threadIdx.x & 63, tok = lane & 31, hh = lane >> 5, w = __builtin_amdgcn_readfirstlane(threadIdx.x >> 6);
    pg8::Tile u;
    for (int i = 0; Sc.next(i, u); ++i) { int h = u.pn; asm volatile("" : "+s"(h)); topk_item(QH, QL, SKH, SKL, ssq, EIDX, GATE, h, u.pm * 256 + 32 * w, tok, hh); }
}
}
namespace p0 {
template <int CTRL> __device__ __forceinline__ float dppf(float v) { return __builtin_bit_cast(float, __builtin_amdgcn_update_dpp(0, __builtin_bit_cast(int, v), CTRL, 0xf, 0xf, true)); }
__device__ __forceinline__ float rl(float v, int l) { return __builtin_bit_cast(float, __builtin_amdgcn_readlane(__builtin_bit_cast(int, v), l)); }
__device__ __forceinline__ float wsum_u(float v) { v += dppf<0xB1>(v); v += dppf<0x4E>(v); v += dppf<0x141>(v); v += dppf<0x140>(v); return (rl(v, 0) + rl(v, 16)) + (rl(v, 32) + rl(v, 48)); }
__device__ __forceinline__ float wmax_u(float v) { v = fmaxf(v, dppf<0xB1>(v)); v = fmaxf(v, dppf<0x4E>(v)); v = fmaxf(v, dppf<0x141>(v)); v = fmaxf(v, dppf<0x140>(v)); return fmaxf(fmaxf(rl(v, 0), rl(v, 16)), fmaxf(rl(v, 32), rl(v, 48))); }
__device__ __forceinline__ unsigned pk2(float lo, float hi) { return (unsigned)f2bf(lo) | ((unsigned)f2bf(hi) << 16); }
struct TrDesc { const float* src; bf16_t* dst; int ldw, pitch, split; };
__device__ __forceinline__ void tr_load(const TrDesc& d, int lane, float (&r)[32]) {
    const int l = lane & 31, adj = l >= d.split ? NHB : 0; const float* s = d.src + (size_t)(lane >> 5) * d.ldw + l + adj;
#pragma unroll
    for (int i = 0; i < 32; ++i) r[i] = s[(size_t)(2 * i) * d.ldw];
}
__device__ __forceinline__ void tr_store(const TrDesc& d, int lane, const float (&r)[32], LAS float* scr) {
#pragma unroll
    for (int i = 0; i < 32; ++i) scr[(2 * i + (lane >> 5)) * 33 + (lane & 31)] = r[i];
    asm volatile("s_waitcnt lgkmcnt(0)" ::: "memory");
    const int c = lane & 7;
#pragma unroll
    for (int j = 0; j < 4; ++j) { const int n = (lane >> 3) + 8 * j; const LAS float* s = scr + (8 * c) * 33 + n;
        uint4 o; o.x = pk2(s[0 * 33], s[1 * 33]); o.y = pk2(s[2 * 33], s[3 * 33]); o.z = pk2(s[4 * 33], s[5 * 33]); o.w = pk2(s[6 * 33], s[7 * 33]);
        *(uint4*)(d.dst + (size_t)n * d.pitch + 8 * c) = o; }
    asm volatile("s_waitcnt lgkmcnt(0)" ::: "memory");
}
struct Args { const float *x, *g1, *w_in, *bfg, *wua, *wub, *wout, *wq, *pu, *pv, *sk; bf16_t *WUT, *WOT, *WQT, *UB, *VB; float* LOGF; bf16_t *SKH, *SKL; unsigned char *XN8, *W8; float *XS, *WS8; float* WFC; unsigned* WFM; };
constexpr int I_1 = 0  , I_UA = 12 * 128, I_UB = 28 * 128, I_O = 64 * 128, I_Q = 64 * 64, NITEMS = I_1 + I_UA + I_UB + I_O + I_Q;
__device__ __forceinline__ TrDesc decode(const Args& a, int it);
__device__ __forceinline__ void transpose_range(const Args& a, LAS float* scr, int lane, int it0, int step, int it_end) {
    float ra[32], rb[32]; int it = it0; TrDesc d0{}, d1{};
    if (it < it_end) { d0 = decode(a, it); tr_load(d0, lane, ra); }
    while (it < it_end) { const int itn = it + step; const bool more = itn < it_end;
        if (more) { d1 = decode(a, itn); tr_load(d1, lane, rb); }
        tr_store(d0, lane, ra, scr);
        if (more) { d0 = d1;
#pragma unroll
            for (int i = 0; i < 32; ++i) ra[i] = rb[i]; }
        it = itn; }
}
__device__ __forceinline__ void prep(const Args& a, LAS unsigned char* lds, int bx, int G, int c_lo, int c_hi) {
    const int tid = threadIdx.x, lane = tid & 63, wave = __builtin_amdgcn_readfirstlane(tid >> 6), gw = bx * 8 + wave, NGW = G * 8;
    LAS float* scr = (LAS float*)(lds + wave * 8448);
    const int nrow = (2 * NEXP + NGW - 1) / NGW, nit = (NITEMS - I_1 + NGW - 1) / NGW;
    for (int c = c_lo; c < c_hi; ++c) {
        { const int j0 = (nrow * c) / 8, j1 = (nrow * (c + 1)) / 8; float4 va[16];
          for (int j = j0; j < j1; ++j) { const int row = gw + NGW * j; if (row < 2 * NEXP) { pr::tq_load(a.pu, a.pv, row, lane, va); pr::tq_pack((unsigned char*)a.UB, (float*)a.VB, row, lane, va); } } }
        { const int j0 = (nit * c) / 8, j1 = (nit * (c + 1)) / 8; if (j1 > j0) transpose_range(a, scr, lane, I_1 + gw + NGW * j0, NGW, (I_1 + gw + NGW * j1) < NITEMS ? (I_1 + gw + NGW * j1) : NITEMS); }
        if (c == 0) for (int i = bx * 512 + tid; i < PH * 2 * NKEYS * PQH; i += G * 512) { const float v = a.sk[i]; const bf16_t hb = f2bf(v); a.SKH[i] = hb; a.SKL[i] = f2bf(v - bf2f(hb)); }
    }
}
__device__ __forceinline__ void gate_w8(const Args& a, LAS unsigned char* lds, int bx, int G) {
    const int tid = threadIdx.x, lane = tid & 63, wave = __builtin_amdgcn_readfirstlane(tid >> 6), c = tid & 15, g = tid >> 4;
    constexpr int P = DM + 16;
    LAS unsigned char* T = lds; LAS float* cm = (LAS float*)(lds + 16 * P);
    const int half = (bx >> 3) & 1, bi = ((bx >> 4) << 3) | (bx & 7), nbase = G >> 1; const bool paired = (G & 15) == 0;
    auto blk = [&](int pj) -> int { return paired ? 2 * (bi + nbase * pj) + half : bx + G * pj; };
    auto srcof = [&](int cb) -> const float* { const int n0 = 16 * cb, n1 = n0 - 2 * (WA + WB);
        const int sc = n0 < 2 * WA ? n0 : (n1 < 0 ? C_QB + n0 - 2 * WA : (n1 < WA ? C_VA + n1 : (n1 < WA + WB ? C_VB + n1 - WA : C_GA + n1 - WA - WB)));
        return a.w_in + (size_t)(4 * g) * INC + sc + c; };
    constexpr int NB = (INC - NHB) / 16;
    float v[32][4];
    if (blk(0) < NB) { const float* src = srcof(blk(0));
#pragma unroll
        for (int i = 0; i < 32; ++i)
#pragma unroll
            for (int j = 0; j < 4; ++j) v[i][j] = src[(size_t)(128 * i + j) * INC]; }
    for (int pj = 0;; ++pj) { const int cb = blk(pj); if (cb >= NB) break; const int n0 = 16 * cb;
        float mx = 0.f;
#pragma unroll
        for (int i = 0; i < 32; ++i)
#pragma unroll
            for (int j = 0; j < 4; ++j) mx = fmaxf(mx, fabsf(v[i][j]));
        mx = fmaxf(mx, __shfl_xor(mx, 16)); mx = fmaxf(mx, __shfl_xor(mx, 32));
        if (lane < 16) cm[wave * 16 + lane] = mx;
        __syncthreads();
        float m = cm[c];
#pragma unroll
        for (int w = 1; w < 8; ++w) m = fmaxf(m, cm[w * 16 + c]);
        const float iv = m > 0.f ? 127.f / m : 0.f;
        if (tid < 16) a.WS8[n0 + tid] = m * (1.f / 127.f);
#pragma unroll
        for (int i = 0; i < 32; ++i) { unsigned pk = 0;
#pragma unroll
            for (int j = 0; j < 4; ++j) pk |= ((unsigned)__float2int_rn(v[i][j] * iv) & 0xffu) << (8 * j);
            *(LAS unsigned*)(T + c * P + 128 * i + 4 * g) = pk; }
        __syncthreads();
        { const int cbn = blk(pj + 1); if (cbn < NB) { const float* src = srcof(cbn);
#pragma unroll
            for (int i = 0; i < 32; ++i)
#pragma unroll
                for (int j = 0; j < 4; ++j) v[i][j] = src[(size_t)(128 * i + j) * INC]; } }
        asm volatile("" ::: "memory");
#pragma unroll
        for (int j = 0; j < 8; ++j) { const int q = tid + 512 * j, cc = q >> 8, off = (q & 255) * 16;
            *(pg8::u32x4*)(a.W8 + (size_t)(n0 + cc) * DM + off) = *(const LAS pg8::u32x4*)(T + cc * P + off); }
        __syncthreads();
    }
}
__device__ __forceinline__ void run(const Args& a, LAS unsigned char* lds, int vcu, int G) {
    const int tid = threadIdx.x, lane = tid & 63, wave = __builtin_amdgcn_readfirstlane(tid >> 6);
    const int gw = vcu * 8 + wave, NGW = G * 8;
    LAS float* scr = (LAS float*)(lds + wave * 8448);
    gate_w8(a, lds, blockIdx.x, G);
    __syncthreads();
    for (int k = blockIdx.x * 512 + tid; k < DM; k += G * 512) { const float2* src = (const float2*)(a.w_in + (size_t)k * INC + C_F);
#pragma unroll
        for (int j = 0; j < 7; ++j) { const float2 v = src[j]; a.WFC[(2 * j) * DM + k] = v.x; a.WFC[(2 * j + 1) * DM + k] = v.y;
            const float m0 = wmax_u(fabsf(v.x)), m1 = wmax_u(fabsf(v.y));
            if (lane == 0) { atomicMax(a.WFM + 2 * j, __float_as_uint(m0)); atomicMax(a.WFM + 2 * j + 1, __float_as_uint(m1)); } } }
    for (int m = gw; m < S; m += NGW) {
        const float4* xr = (const float4*)(a.x + (size_t)m * DM); float v[8][8]; float ss = 0.f;
#pragma unroll
        for (int j = 0; j < 8; ++j) { const float4 p = xr[j * 128 + 2 * lane], q = xr[j * 128 + 2 * lane + 1];
            v[j][0] = p.x; v[j][1] = p.y; v[j][2] = p.z; v[j][3] = p.w; v[j][4] = q.x; v[j][5] = q.y; v[j][6] = q.z; v[j][7] = q.w;
            ss += (p.x * p.x + p.y * p.y) + (p.z * p.z + p.w * p.w) + (q.x * q.x + q.y * q.y) + (q.z * q.z + q.w * q.w); }
        const float rstd = rsqrtf(wsum_u(ss) * (1.f / DM) + EPS);
#pragma unroll
        for (int j = 0; j < 8; ++j) { const float4 p = ((const float4*)a.g1)[j * 128 + 2 * lane], q = ((const float4*)a.g1)[j * 128 + 2 * lane + 1];
            v[j][0] *= rstd * p.x; v[j][1] *= rstd * p.y; v[j][2] *= rstd * p.z; v[j][3] *= rstd * p.w; v[j][4] *= rstd * q.x; v[j][5] *= rstd * q.y; v[j][6] *= rstd * q.z; v[j][7] *= rstd * q.w;
        }
        { float am = 0.f;
#pragma unroll
          for (int j = 0; j < 8; ++j)
#pragma unroll
              for (int e = 0; e < 8; ++e) am = fmaxf(am, fabsf(v[j][e]));
          am = wmax_u(am); const float iv = am > 0.f ? 127.f / am : 0.f;
#pragma unroll
          for (int j = 0; j < 8; ++j) { unsigned lo = 0, hi = 0;
#pragma unroll
              for (int b = 0; b < 4; ++b) { lo |= ((unsigned)__float2int_rn(v[j][b] * iv) & 0xffu) << (8 * b); hi |= ((unsigned)__float2int_rn(v[j][4 + b] * iv) & 0xffu) << (8 * b); }
              *(uint2*)(a.XN8 + (size_t)m * DM + j * 512 + 8 * lane) = make_uint2(lo, hi); }
          if (lane == 0) a.XS[m] = am * (1.f / 127.f); }
    }
}
__device__ __forceinline__ void flogits(const Args& a, LAS unsigned char* lds, int vcu, int G) {
    const int tid = threadIdx.x, lane = tid & 63, wave = __builtin_amdgcn_readfirstlane(tid >> 6), gw = vcu * 8 + wave, NGW = G * 8;
    for (int i = tid; i < NHB * (DM / 4); i += 512) { const int h = i / (DM / 4), k4 = i % (DM / 4); const float m = __uint_as_float(a.WFM[h]); const float iv = m > 0.f ? 127.f / m : 0.f;
        const float4 v = *(const float4*)(a.WFC + (size_t)h * DM + 4 * k4);
        *(LAS unsigned*)(lds + h * DM + 4 * k4) = ((unsigned)__float2int_rn(v.x * iv) & 0xffu) | (((unsigned)__float2int_rn(v.y * iv) & 0xffu) << 8) | (((unsigned)__float2int_rn(v.z * iv) & 0xffu) << 16) | ((unsigned)__float2int_rn(v.w * iv) << 24); }
    __syncthreads();
    const float ws = lane < NHB ? __uint_as_float(a.WFM[lane]) * (1.f / 127.f) : 0.f, bf = lane < NHB ? a.bfg[lane] : 0.f;
    pg8::u32x4 xn_[4];
    if (gw < S) {
#pragma unroll
        for (int j = 0; j < 4; ++j) xn_[j] = *(const pg8::u32x4*)(a.XN8 + (size_t)gw * DM + j * 1024 + lane * 16); }
    for (int m = gw; m < S; m += NGW) {
        pg8::u32x4 xr[4];
#pragma unroll
        for (int j = 0; j < 4; ++j) xr[j] = xn_[j];
        if (m + NGW < S) {
#pragma unroll
            for (int j = 0; j < 4; ++j) xn_[j] = *(const pg8::u32x4*)(a.XN8 + (size_t)(m + NGW) * DM + j * 1024 + lane * 16); }
        const float xs = a.XS[m]; int dl = 0;
#pragma unroll 2
        for (int h = 0; h < NHB; ++h) { int d = 0;
#pragma unroll
            for (int j = 0; j < 4; ++j) { const pg8::u32x4 w = *(const LAS pg8::u32x4*)(lds + h * DM + j * 1024 + lane * 16);
#pragma unroll
                for (int q = 0; q < 4; ++q) d = __builtin_amdgcn_sdot4((int)xr[j][q], (int)w[q], d, false); }
            d = pr::wave_sum_i_u(d); dl = (lane == h) ? d : dl; }
        if (lane < NHB) { const float z = (float)dl * xs * ws + bf; a.LOGF[m * 16 + lane] = fminf(z, 0.f) - log1pf(expf(-fabsf(z))); }
    }
    __syncthreads();
}
__device__ __forceinline__ TrDesc decode(const Args& a, int it) { int r = it; TrDesc d;
    if (r < I_UA) { const int kb = r / 128, nb = r % 128; d.src = a.wua + (size_t)(64 * kb) * DM + 32 * nb; d.ldw = DM; d.split = 32; d.dst = a.WUT + (size_t)(32 * nb) * YW + 64 * kb; d.pitch = YW; return d; } r -= I_UA;
    if (r < I_UB) { const int kb = r / 128, nb = r % 128; d.src = a.wub + (size_t)(64 * kb) * DM + 32 * nb; d.ldw = DM; d.split = 32; d.dst = a.WUT + WAO + (size_t)(32 * nb) * YW + 64 * kb; d.pitch = YW; return d; } r -= I_UB;
    if (r < I_O) { const int kb = r / 128, nb = r % 128; d.src = a.wout + (size_t)(64 * kb) * DM + 32 * nb; d.ldw = DM; d.split = 32; d.dst = a.WOT + (size_t)(32 * nb) * DM + 64 * kb; d.pitch = DM; return d; } r -= I_O;
    { const int kb = r / 64, nb = r % 64; d.src = a.wq + (size_t)(64 * kb) * PQW + 32 * nb; d.ldw = PQW; d.split = 32; d.dst = a.WQT + (size_t)(32 * nb) * DM + 64 * kb; d.pitch = DM; return d; } }
}
namespace att {
typedef short bf16x8 __attribute__((ext_vector_type(8)));
typedef short s16x4 __attribute__((ext_vector_type(4)));
typedef float f32x16 __attribute__((ext_vector_type(16)));
typedef float f32x4 __attribute__((ext_vector_type(4)));
typedef unsigned u32x4 __attribute__((ext_vector_type(4)));
typedef unsigned u32x2 __attribute__((ext_vector_type(2)));
constexpr int KOFF = 0, VOFF = 32768, COFF = 65536, LDS_BYTES = 66048;
struct Unit { const char* q; const char* k; const char* v; size_t pitch; int i0; const float* c2; float slope2; char* o; size_t opitch; float* mo; float* lo; int mpitch; float thr; };
#define ATT_MFMA(a, b, c) __builtin_amdgcn_mfma_f32_32x32x16_bf16((a), (b), (c), 0, 0, 0)
__device__ __forceinline__ unsigned pk_bf16(float lo, float hi) { return pg8::cvt_pk_bf16(lo, hi); }

template <bool FOX>
__device__ __forceinline__ void unit(LAS unsigned char* lds, const Unit& u) {
    const int tid = threadIdx.x, w = __builtin_amdgcn_readfirstlane(tid >> 6), lane = tid & 63, c = lane & 31, h = lane >> 5;
    const int imin = u.i0 + 32 * w, imax = imin + 31, irow = imin + c;
    int T_lo = (u.i0 - 128 > 0 ? u.i0 - 128 : 0) >> 6; const int T_hi = (u.i0 + 255) >> 6;
    if (FOX) {
        const int nT = u.i0 >> 6; const float c0 = u.c2[u.i0]; T_lo = nT;
        for (int base = 0; base < nT; base += 64) { const int tl = base + lane; const bool keep = (tl < nT) ? (c0 - u.c2[64 * tl + 63] > -u.thr) : true;
            const unsigned long long bm = __ballot(keep); if (bm) { const int f = base + __ffsll((long long)bm) - 1; T_lo = f < nT ? f : nT; break; } }
        T_lo = __builtin_amdgcn_readfirstlane(T_lo);
    }
    const int w_lo = FOX ? T_lo : ((imin - 128 > 0 ? imin - 128 : 0) >> 6), w_hi = imax >> 6;
    const int dr = lane >> 4, dp = lane & 15;
    unsigned ksrc[2], vsrc[2];
#pragma unroll
    for (int j = 0; j < 2; ++j) { const int row = 8 * w + 4 * j + dr; ksrc[j] = (unsigned)(row * u.pitch) + ((dp ^ (row & 15)) << 4); vsrc[j] = (unsigned)(row * u.pitch) + ((dp ^ ((row & 3) << 2)) << 4); }
    const size_t tstep = 64 * u.pitch;
#define ATT_ISSUE(T, b) do { const char* kb_ = u.k + (size_t)(T) * tstep; const char* vb_ = u.v + (size_t)(T) * tstep; \
        _Pragma("unroll") for (int j_ = 0; j_ < 2; ++j_) { \
            __builtin_amdgcn_global_load_lds((const unsigned*)(kb_ + ksrc[j_]), (LAS unsigned*)(lds + KOFF + (b) * 16384 + (8 * w + 4 * j_) * 256), 16, 0, 0); \
            __builtin_amdgcn_global_load_lds((const unsigned*)(vb_ + vsrc[j_]), (LAS unsigned*)(lds + VOFF + (b) * 16384 + (8 * w + 4 * j_) * 256), 16, 0, 0); } \
        if (FOX && w == 0) __builtin_amdgcn_global_load_lds((const unsigned*)(u.c2 + (T) * 64 + lane), (LAS unsigned*)(lds + COFF + (b) * 256), 4, 0, 0); } while (0)
    int koff[8], voff[4];
#pragma unroll
    for (int ks = 0; ks < 8; ++ks) koff[ks] = c * 256 + (((2 * ks + h) ^ (lane & 15)) << 4);
    { const int q4 = (lane & 15) >> 2, gi = (lane >> 4) & 1, p = lane & 3;
#pragma unroll
      for (int dg = 0; dg < 4; ++dg) voff[dg] = (4 * h + q4) * 256 + ((4 * (dg ^ q4) + 2 * gi + (p >> 1)) << 4) + 8 * (p & 1); }
    bf16x8 qf[8];
    { const char* qrow = u.q + (size_t)irow * u.pitch + h * 16;
#pragma unroll
      for (int ks = 0; ks < 8; ++ks) qf[ks] = *(const bf16x8*)(qrow + ks * 32); }
    const float ci = FOX ? u.c2[irow] : 0.f;
    float m = -1e30f, l = 0.f;
    f32x16 O[4];
#pragma unroll
    for (int dg = 0; dg < 4; ++dg)
#pragma unroll
        for (int r = 0; r < 16; ++r) O[dg][r] = 0.f;
    asm volatile("" ::: "memory"); __builtin_amdgcn_s_barrier(); asm volatile("" ::: "memory");
    ATT_ISSUE(T_lo, 0);
    int b = 0;
    for (int T = T_lo; T <= T_hi; ++T, b ^= 1) {
        asm volatile("s_waitcnt vmcnt(0)" ::: "memory");
        __builtin_amdgcn_s_barrier(); asm volatile("" ::: "memory");
        if (T < T_hi) ATT_ISSUE(T + 1, b ^ 1);
        if (T < w_lo || T > w_hi) continue;
        const LAS unsigned char* kb = lds + KOFF + b * 16384; const LAS unsigned char* vb = lds + VOFF + b * 16384;
        f32x16 S0, S1;
#pragma unroll
        for (int r = 0; r < 16; ++r) { S0[r] = 0.f; S1[r] = 0.f; }
#pragma unroll
        for (int ks = 0; ks < 8; ++ks) { const bf16x8 k0 = *(const LAS bf16x8*)(kb + koff[ks]), k1 = *(const LAS bf16x8*)(kb + 8192 + koff[ks]);
            S0 = ATT_MFMA(k0, qf[ks], S0); S1 = ATT_MFMA(k1, qf[ks], S1); }
        const int j0 = T * 64 + 4 * h;
        if (FOX) { const LAS float* cb = (const LAS float*)(lds + COFF + b * 256) + 4 * h;
#pragma unroll
            for (int g4 = 0; g4 < 4; ++g4) { const f32x4 c0 = *(const LAS f32x4*)(cb + 8 * g4), c1 = *(const LAS f32x4*)(cb + 32 + 8 * g4);
#pragma unroll
                for (int e = 0; e < 4; ++e) { S0[4 * g4 + e] += ci - c0[e]; S1[4 * g4 + e] += ci - c1[e]; } }
        } else { const float d0 = u.slope2 * (float)(j0 - irow);
#pragma unroll
            for (int r = 0; r < 16; ++r) { S0[r] += d0 + u.slope2 * (float)((r & 3) + 8 * (r >> 2)); S1[r] += d0 + u.slope2 * (float)(32 + (r & 3) + 8 * (r >> 2)); } }
        const bool need_mask = (T * 64 + 63 > imin) || (!FOX && T * 64 < imax - 128);
        if (need_mask) { const unsigned lim = FOX ? 0x7fffffffu : 128u; const int dj = irow - j0;
#pragma unroll
            for (int r = 0; r < 16; ++r) { const int kk = (r & 3) + 8 * (r >> 2);
                S0[r] = ((unsigned)(dj - kk) <= lim) ? S0[r] : -INFINITY; S1[r] = ((unsigned)(dj - kk - 32) <= lim) ? S1[r] : -INFINITY; } }
        float mx = fmaxf(S0[0], S1[0]);
#pragma unroll
        for (int r = 1; r < 16; ++r) mx = fmaxf(mx, fmaxf(S0[r], S1[r]));
        mx = fmaxf(mx, __shfl_xor(mx, 32));
        const float mn = fmaxf(m, mx), alpha = __builtin_amdgcn_exp2f(m - mn); m = mn;
        float ps = 0.f;
#pragma unroll
        for (int r = 0; r < 16; ++r) { S0[r] = __builtin_amdgcn_exp2f(S0[r] - mn); S1[r] = __builtin_amdgcn_exp2f(S1[r] - mn); ps += S0[r] + S1[r]; }
        l = l * alpha + ps;
#pragma unroll
        for (int dg = 0; dg < 4; ++dg)
#pragma unroll
            for (int r = 0; r < 16; ++r) O[dg][r] *= alpha;
        bf16x8 pf[4];
#pragma unroll
        for (int s = 0; s < 4; ++s) { u32x4 pk;
#pragma unroll
            for (int e = 0; e < 4; ++e) { const int r = 8 * (s & 1) + 2 * e; pk[e] = (s < 2) ? pk_bf16(S0[r], S0[r + 1]) : pk_bf16(S1[r], S1[r + 1]); }
            pf[s] = __builtin_bit_cast(bf16x8, pk); }
#pragma unroll
        for (int s = 0; s < 4; ++s)
#pragma unroll
            for (int dg = 0; dg < 4; ++dg) {
                const s16x4 lo = __builtin_amdgcn_ds_read_tr16_b64_v4i16((LAS s16x4*)(vb + voff[dg] + s * 4096));
                const s16x4 hi = __builtin_amdgcn_ds_read_tr16_b64_v4i16((LAS s16x4*)(vb + voff[dg] + s * 4096 + 2048));
                const bf16x8 vf = __builtin_shufflevector(lo, hi, 0, 1, 2, 3, 4, 5, 6, 7);
                O[dg] = ATT_MFMA(vf, pf[s], O[dg]); }
    }
    const float lt = l + __shfl_xor(l, 32), inv = 1.f / lt;
    char* orow = u.o + (size_t)irow * u.opitch + h * 8;
#pragma unroll
    for (int dg = 0; dg < 4; ++dg)
#pragma unroll
        for (int g4 = 0; g4 < 4; ++g4) { u32x2 wv; wv.x = pk_bf16(O[dg][4 * g4] * inv, O[dg][4 * g4 + 1] * inv); wv.y = pk_bf16(O[dg][4 * g4 + 2] * inv, O[dg][4 * g4 + 3] * inv);
            *(u32x2*)(orow + dg * 64 + g4 * 16) = wv; }
    if (!FOX && h == 0) { u.mo[(size_t)irow * u.mpitch] = m; u.lo[(size_t)irow * u.mpitch] = lt; }
#undef ATT_ISSUE
}
__device__ __forceinline__ void scan_head(const float* __restrict__ logf, float* __restrict__ c2, int h, LAS float* part) {
    const int tid = threadIdx.x; float v[16]; float s = 0.f;
#pragma unroll
    for (int i = 0; i < 16; ++i) { s += logf[(tid * 16 + i) * 16 + h]; v[i] = s; }
    part[tid] = s; __syncthreads();
    for (int o = 1; o < 512; o <<= 1) { const float t = (tid >= o) ? part[tid - o] : 0.f; __syncthreads(); part[tid] += t; __syncthreads(); }
    const float base = tid ? part[tid - 1] : 0.f;
#pragma unroll
    for (int i = 0; i < 16; ++i) c2[(size_t)h * S + tid * 16 + i] = (base + v[i]) * LOG2E;
    __syncthreads();
}
__device__ __forceinline__ void phase_a(LAS unsigned char* lds, const bf16_t* QA, const bf16_t* KA, const bf16_t* VA, bf16_t* OA, float* MA, float* LA, int vcu, int G) {
    for (int it = vcu; it < NHA * 32; it += G) {
        const int hd = it >> 5, uu = it & 31, g = hd / 6, r = group_dil(g), nper = 32 / r, cc = uu / nper, n = uu % nper;
        Unit u; const size_t off = ((size_t)cc * WA + hd * HD) * 2;
        u.q = (const char*)QA + off; u.k = (const char*)KA + off; u.v = (const char*)VA + off; u.pitch = (size_t)r * WA * 2; u.i0 = n * 256; u.c2 = nullptr;
        u.slope2 = exp2f(-8.f * (float)(hd + 1) / 18.f) * (float)r * LOG2E; u.o = (char*)OA + off; u.opitch = u.pitch; u.mo = MA + cc * NHA + hd; u.lo = LA + cc * NHA + hd; u.mpitch = r * NHA; u.thr = 0.f;
        unit<false>(lds, u);
    }
}
__device__ __forceinline__ void phase_b(LAS unsigned char* lds, const bf16_t* QB, const bf16_t* KB, const bf16_t* VB, const float* C2, bf16_t* Y, const float* gq, const float* gk, int vcu, int G) {
    float thr; { const int lane = threadIdx.x & 63; const float a = wave_max(fmaxf(fabsf(gq[lane]), fabsf(gq[lane + 64]))), b = wave_max(fmaxf(fabsf(gk[lane]), fabsf(gk[lane + 64]))); thr = 38.f + 2.f * (128.f * QSCALE * a * b); }
    for (int pass = 0; pass * G < NHB * 32; ++pass) {
        const int idx = (pass & 1) ? (pass + 1) * G - 1 - vcu : pass * G + vcu; if (idx >= NHB * 32) continue;
        const int blk = 31 - idx / NHB, hd = idx % NHB;
        Unit u; u.q = (const char*)QB + hd * HD * 2; u.k = (const char*)KB + hd * HD * 2; u.v = (const char*)VB + hd * HD * 2; u.pitch = (size_t)WB * 2; u.i0 = blk * 256; u.c2 = C2 + (size_t)hd * S;
        u.slope2 = 0.f; u.o = (char*)Y + (WAO + hd * HD) * 2; u.opitch = (size_t)YW * 2; u.mo = nullptr; u.lo = nullptr; u.mpitch = 0; u.thr = thr;
        unit<true>(lds, u);
    }
}
__device__ __forceinline__ void phase_merge(const bf16_t* __restrict__ OA, const float* __restrict__ MA, const float* __restrict__ LA, bf16_t* __restrict__ Y, int vcu, int G) {
    const int lane = threadIdx.x & 63, gw = vcu * 8 + __builtin_amdgcn_readfirstlane(threadIdx.x >> 6), NGW = G * 8, sub = lane >> 4, dl = lane & 15;
#pragma unroll 2
    for (int it = gw; it < S * 6 / 4; it += NGW) { const int pr = it * 4 + sub, t = pr / 6, j = pr % 6;
        float mg[3], lg[3]; u32x4 ov[3];
#pragma unroll
        for (int g = 0; g < 3; ++g) { mg[g] = MA[t * NHA + g * 6 + j]; lg[g] = LA[t * NHA + g * 6 + j]; ov[g] = *(const u32x4*)(OA + (size_t)t * WA + (g * 6 + j) * HD + 8 * dl); }
        const float ms = fmaxf(mg[0], fmaxf(mg[1], mg[2]));
        float num[8], den = 0.f;
#pragma unroll
        for (int e = 0; e < 8; ++e) num[e] = 0.f;
#pragma unroll
        for (int g = 0; g < 3; ++g) { const float wl = exp2f(mg[g] - ms) * lg[g]; den += wl;
#pragma unroll
            for (int e = 0; e < 4; ++e) { num[2 * e] += wl * __uint_as_float(ov[g][e] << 16); num[2 * e + 1] += wl * __uint_as_float(ov[g][e] & 0xffff0000u); } }
        const float inv = 1.f / den; u32x4 o;
#pragma unroll
        for (int e = 0; e < 4; ++e) o[e] = pk_bf16(num[2 * e] * inv, num[2 * e + 1] * inv);
        *(u32x4*)(Y + (size_t)t * YW + j * HD + 8 * dl) = o; }
}
}
constexpr int MEGA_LDS = 147456;
constexpr int LDS_CTL_OFF = 131072 + 8192;
struct MArgs { const float* in[16]; float* out; unsigned char* ws; int ph_lo, ph_hi; };
__global__ void __launch_bounds__(512, 2) mega(MArgs a) {
    extern __shared__ __attribute__((aligned(16))) unsigned char lds_raw[];
    LAS unsigned char* lds = (LAS unsigned char*)lds_raw;
    const int tid = threadIdx.x, G = gridDim.x, bx = blockIdx.x;
    const int vcu = (G % 8 == 0) ? (bx % 8) * (G / 8) + bx / 8 : bx;
    unsigned char* ws = a.ws;
    volatile LAS unsigned* ctlw = (volatile LAS unsigned*)(lds + LDS_CTL_OFF);
    if (tid < 16) ctlw[tid] = 0u;
    __syncthreads();
    XcdBarrier bar = xcd_barrier_post((unsigned*)(ws + WS_CTL) + 4096, ctlw);
    const int lo = a.ph_lo, hi = a.ph_hi;
#define IN(k) (lo <= (k) && (k) < hi)
#define BOTH(k) (IN(k) && IN((k) + 1))
    p0::Args pa{a.in[0], a.in[1], a.in[2], a.in[3], a.in[8], a.in[9], a.in[10], a.in[12], a.in[14], a.in[15], a.in[13],
                (bf16_t*)(ws + WS_WUT), (bf16_t*)(ws + WS_WOT), (bf16_t*)(ws + WS_WQT), (bf16_t*)(ws + WS_UB), (bf16_t*)(ws + WS_VB), (float*)(ws + WS_LOGF), (bf16_t*)(ws + WS_WFT), (bf16_t*)(ws + WS_WFT) + PH * 2 * NKEYS * PQH,
                (unsigned char*)(ws + WS_XN8), (unsigned char*)(ws + WS_W8), (float*)(ws + WS_XS), (float*)(ws + WS_WS8), (float*)(ws + WS_LOGF + 512 * 1024), (unsigned*)(ws + WS_CTL) + 128};
    if (IN(0)) {
        p0::run(pa, lds, vcu, G);
        if (BOTH(0)) xcd_barrier(bar);
    }
    if (IN(1)) {
        pg8::Sched1 S1{(const char*)(ws + WS_XN8), (const char*)(ws + WS_W8), G, bx, 32, DM / 128, DM, DM};
        pg8::Epi1 E1{ws, (const float*)(ws + WS_XS), (const float*)(ws + WS_WS8), a.in[4], a.in[5], a.in[6], a.in[7]};
        p0::flogits(pa, lds, vcu, G);
        p0::prep(pa, lds, bx, G, 0, bx & 7);
        __syncthreads();
        pg8::gemm_phase<pg8::Epi1, pg8::Sched1, true>(lds, S1, E1);
        { pg8::Sched1 S8{(const char*)(ws + WS_XN8), (const char*)(ws + WS_W8) + (size_t)8192 * DM, G, bx, 48, DM / 128, DM, DM};
          pg8::EpiGate8 E8{ws, (const float*)(ws + WS_XS), (const float*)(ws + WS_WS8) + 8192};
          pg8::gemm_phase<pg8::EpiGate8, pg8::Sched1, true>(lds, S8, E8); }
        p0::prep(pa, lds, bx, G, bx & 7, 8);
        if (BOTH(1)) xcd_barrier(bar);
    }
    if (IN(2)) {
        if (bx < NHB) att::scan_head((const float*)(ws + WS_LOGF), (float*)(ws + WS_C2), bx, (LAS float*)lds);
        att::phase_a(lds, (const bf16_t*)(ws + WS_QA), (const bf16_t*)(ws + WS_KA), (const bf16_t*)(ws + WS_VAN), (bf16_t*)(ws + WS_OA), (float*)(ws + WS_MA), (float*)(ws + WS_LA), vcu, G);
        if (BOTH(2)) xcd_barrier(bar);
    }
    if (IN(3)) {
        att::phase_b(lds, (const bf16_t*)(ws + WS_QB), (const bf16_t*)(ws + WS_KB), (const bf16_t*)(ws + WS_VBN), (const float*)(ws + WS_C2), (bf16_t*)(ws + WS_Y), a.in[6], a.in[7], vcu, G);
        att::phase_merge((const bf16_t*)(ws + WS_OA), (const float*)(ws + WS_MA), (const float*)(ws + WS_LA), (bf16_t*)(ws + WS_Y), vcu, G);
        if (BOTH(3)) xcd_barrier(bar);
    }
    if (IN(4)) {
        pg8::SchedUp SU{(const char*)(ws + WS_Y), (const char*)(ws + WS_WUT), G, bx, YW * 2, YW * 2};
        pg8::EpiUp EU{(const unsigned char*)(ws + WS_GA), (const unsigned char*)(ws + WS_GB), (bf16_t*)(ws + WS_MERGED)};
        pg8::gemm_phase<pg8::EpiUp, pg8::SchedUp>(lds, SU, EU);
        if (BOTH(4)) xcd_barrier(bar);
    }
    if (IN(5)) {
        pg8::SchedPlain SO{(const char*)(ws + WS_MERGED), (const char*)(ws + WS_WOT), G, bx, 32, 16, DM, DM * 2, DM * 2};
        pg8::EpiOut EO{a.in[0], a.in[11], a.out, (bf16_t*)(ws + WS_XN), (float*)(ws + WS_SSQ)};
        pg8::gemm_phase<pg8::EpiOut, pg8::SchedPlain>(lds, SO, EO);
        if (BOTH(5)) xcd_barrier(bar);
    }
    if (IN(6)) {
        pg8::SchedPlain SQ{(const char*)(ws + WS_XN), (const char*)(ws + WS_WQT), G, bx, 32, 8, DM, DM * 2, DM * 2};
        pg8::EpiHiLo EQ{(bf16_t*)(ws + WS_QP), (bf16_t*)(ws + WS_QP) + (size_t)S * PQW, PQW, 0};
        pg8::gemm_phase<pg8::EpiHiLo, pg8::SchedPlain>(lds, SQ, EQ);
        tk::phase_topk2_tiles((const bf16_t*)(ws + WS_QP), (const bf16_t*)(ws + WS_QP) + (size_t)S * PQW, (const bf16_t*)(ws + WS_WFT), (const bf16_t*)(ws + WS_WFT) + PH * 2 * NKEYS * PQH, (const float*)(ws + WS_SSQ), (int*)(ws + WS_EIDX), (float*)(ws + WS_GATE), SQ);
        pr::quant_tokens((const bf16_t*)(ws + WS_XN), (unsigned char*)(ws + WS_MERGED), (float*)(ws + WS_MA), vcu * 8 + __builtin_amdgcn_readfirstlane(tid >> 6), G * 8, tid & 63);
        if (BOTH(6)) xcd_barrier(bar);
    }
    if (IN(8)) {
        if ((G & 7) == 0) {
            pr::phase_udot((const unsigned char*)(ws + WS_MERGED), (const int*)(ws + WS_EIDX), (const unsigned char*)(ws + WS_UB), (int*)(ws + WS_OA), bx, G);
            xcd_barrier(bar);
            pr::phase_vsum2((const int*)(ws + WS_OA), (const float*)(ws + WS_MA), (const float*)(ws + WS_SSQ), (const int*)(ws + WS_EIDX), (const float*)(ws + WS_GATE), (const unsigned char*)(ws + WS_UB) + (size_t)NEXP * DM,
                           (const float*)(ws + WS_VB), (const float*)(ws + WS_VB) + NEXP, a.out, vcu, G);
        } else {
            pr::phase_gather8((const bf16_t*)(ws + WS_XN), (const float*)(ws + WS_SSQ), (const int*)(ws + WS_EIDX), (const float*)(ws + WS_GATE), (const unsigned char*)(ws + WS_UB), (const unsigned char*)(ws + WS_UB) + (size_t)NEXP * DM,
                              (const float*)(ws + WS_VB), (const float*)(ws + WS_VB) + NEXP, a.out, vcu, G);
        }
    }
#undef IN
#undef BOTH
}
static int mega_grid() {
    static int grid = 0;
    if (!grid) { int dev = 0, cus = 0, per_cu = 0; hipGetDevice(&dev); hipDeviceGetAttribute(&cus, hipDeviceAttributeMultiprocessorCount, dev);
        hipFuncSetAttribute((const void*)mega, hipFuncAttributeMaxDynamicSharedMemorySize, MEGA_LDS);
        hipOccupancyMaxActiveBlocksPerMultiprocessor(&per_cu, (const void*)mega, 512, MEGA_LDS);
        if (per_cu < 1) fprintf(stderr, "mega: occupancy query says %d blocks per CU\n", per_cu);
        grid = cus; }
    return grid;
}
static void launch_mega(void* const* d_in, float* out, unsigned char* ws, hipStream_t st, int lo, int hi) {
    MArgs a{}; for (int i = 0; i < 16; ++i) a.in[i] = (const float*)d_in[i]; a.out = out; a.ws = ws; a.ph_lo = lo; a.ph_hi = hi;
    hipLaunchKernelGGL(mega, dim3(mega_grid()), dim3(512), MEGA_LDS, st, a);
}
extern "C" void kernel_launch(void* const* d_in, const int* in_sizes, int n_in, void* d_out, int out_size, void* d_ws, size_t ws_size, hipStream_t stream) {
    if (n_in != 16 || out_size != S * DM || ws_size < WS_END) { fprintf(stderr, "kernel_launch: unexpected sizes n_in %d out %d ws %zu\n", n_in, out_size, ws_size); return; }
    unsigned char* ws = (unsigned char*)d_ws;
    hipMemsetAsync(ws + WS_CTL, 0, 1 * MiB, stream);
    launch_mega(d_in, (float*)d_out, ws, stream, 0, 9);
}
```

```cpp
#include <hip/hip_runtime.h>
#include <cstdio>
#include <cstdint>

constexpr int S = 8192, DM = 4096, HD = 128;
constexpr int NHA = 18, NHB = 14, WA = NHA * HD  , WB = NHB * HD  , WAO = 6 * HD  ;
constexpr int INC = 3 * WA + 3 * WB + NHB + 2 * DM;
constexpr int C_QA = 0, C_KA = WA, C_VA = 2 * WA, C_QB = 3 * WA, C_KB = 3 * WA + WB, C_VB = 3 * WA + 2 * WB, C_F = 3 * WA + 3 * WB, C_GA = C_F + NHB, C_GB = C_GA + DM;
constexpr int YW = WAO + WB;
constexpr int PH = 8, NKEYS = 128, TOPK = 16, PQD = 256, PQH = 128, PQW = PH * PQD  , NEXP = NKEYS * NKEYS, PK = PH * TOPK  ;
constexpr float EPS = 1e-6f;
constexpr float LOG2E = 1.4426950408889634f;
constexpr float QSCALE = 0.08838834764831845f * LOG2E;

constexpr size_t MiB = 1ull << 20;
constexpr size_t WS_CTL = 0, WS_LOGF = 1 * MiB, WS_C2 = 2 * MiB, WS_MA = 3 * MiB, WS_LA = 4 * MiB, WS_SSQ = 5 * MiB, WS_EIDX = 8 * MiB, WS_GATE = 12 * MiB;
constexpr size_t WS_XN = 16 * MiB, WS_QA = 80 * MiB, WS_KA = 116 * MiB, WS_VAN = 152 * MiB, WS_QB = 188 * MiB, WS_KB = 216 * MiB, WS_VBN = 244 * MiB, WS_GA = 272 * MiB, WS_GB = 336 * MiB;
constexpr size_t WS_OA = 400 * MiB, WS_Y = 436 * MiB, WS_MERGED = 476 * MiB, WS_QP = 540 * MiB, WS_UB = 604 * MiB, WS_VB = 732 * MiB;
constexpr size_t WS_WFT = 1020 * MiB, WS_WUT = 1021 * MiB  , WS_WOT = 1041 * MiB, WS_WQT = 1073 * MiB, WS_XN8 = 1089 * MiB  , WS_XS = 1121 * MiB, WS_W8 = 860 * MiB  , WS_WS8 = 1170 * MiB, WS_END = 1171 * MiB;

#define LAS __attribute__((address_space(3)))
typedef unsigned short bf16_t;
__device__ __forceinline__ float bf2f(bf16_t b) { return __uint_as_float(((unsigned)b) << 16); }
__device__ __forceinline__ bf16_t f2bf(float f) { unsigned u = __float_as_uint(f); u += 0x7fffu + ((u >> 16) & 1u); return (bf16_t)(u >> 16); }
__device__ __forceinline__ float wave_sum(float v) {
#pragma unroll
    for (int o = 1; o < 64; o <<= 1) v += __shfl_xor(v, o);
    return v;
}
__device__ __forceinline__ float wave_max(float v) {
#pragma unroll
    for (int o = 1; o < 64; o <<= 1) v = fmaxf(v, __shfl_xor(v, o));
    return v;
}
__device__ __forceinline__ int wave_min_i(int v) {
#pragma unroll
    for (int o = 1; o < 64; o <<= 1) { int t = __shfl_xor(v, o); v = t < v ? t : v; }
    return v;
}
__device__ __forceinline__ int dil_pos(int t, int r) { return (t % r) * (S / r) + t / r; }
__device__ __forceinline__ int group_dil(int g) { return g == 0 ? 1 : (g == 1 ? 4 : 16); }
#define XB_TMO      128
#define XB_XCNT(j)  (256  + 64 * (j))
#define XB_XSUB(j)  (1280 + 64 * (j))
#define XB_XGEN(j)  (2304 + 64 * (j))
#define XB_TOP      3328
#define XB_TOPGEN   3392
#define XCD_BAR_WORDS 3456
#define XB_SPIN_CAP (1u << 18)
#ifndef LAS
#define LAS __attribute__((address_space(3)))
#endif
__device__ __forceinline__ unsigned xb_ld(unsigned* p)              { return __hip_atomic_load(p, __ATOMIC_RELAXED, __HIP_MEMORY_SCOPE_AGENT); }
__device__ __forceinline__ unsigned xb_add(unsigned* p, unsigned v) { return __hip_atomic_fetch_add(p, v, __ATOMIC_RELAXED, __HIP_MEMORY_SCOPE_AGENT); }
__device__ __forceinline__ unsigned xb_xcc_id() { return (unsigned)__builtin_amdgcn_s_getreg((3 << 11) | 20) & 0xFu; }
#define XB_SPIN(cond, bar) do { unsigned _sp = 0; while (cond) { __builtin_amdgcn_s_sleep(1); \
    if ((++_sp & 255u) == 0u) { if (xb_ld(&(bar)[XB_TMO])) break; if (_sp > XB_SPIN_CAP) { atomicAdd(&(bar)[XB_TMO], 1u); break; } } } } while (0)
struct XcdBarrier { unsigned* bar; unsigned x; volatile LAS unsigned* st; };
__device__ __forceinline__ XcdBarrier xcd_barrier_post(unsigned* bar, volatile LAS unsigned* st) {
    XcdBarrier b; b.bar = bar; b.x = xb_xcc_id(); b.st = st;
    if (threadIdx.x == 0) (void)xb_add(&bar[XB_XCNT(b.x)], 1u);
    return b;
}
__device__ __forceinline__ void xcd_barrier_complete(unsigned* bar, unsigned x, unsigned& nloc, unsigned& nx) {
    const unsigned G = gridDim.x * gridDim.y * gridDim.z;
    unsigned sum, cnt, mine, sp = 0u;
    for (;;) {
        sum = 0u; cnt = 0u; mine = 0u;
#pragma unroll
        for (unsigned j = 0; j < 16; ++j) { const unsigned c = xb_ld(&bar[XB_XCNT(j)]); sum += c; cnt += (c > 0u) ? 1u : 0u; mine = (j == x) ? c : mine; }
        if (sum == G) break;
        __builtin_amdgcn_s_sleep(1);
        if ((++sp & 255u) == 0u) { if (xb_ld(&bar[XB_TMO])) break; if (sp > XB_SPIN_CAP) { atomicAdd(&bar[XB_TMO], 1u); break; } }
    }
    nloc = mine > 0u ? mine : 1u; nx = cnt > 0u ? cnt : 1u;
}
__device__ __forceinline__ void xcd_barrier(const XcdBarrier& b) {
    asm volatile("s_waitcnt vmcnt(0)" ::: "memory");
    __syncthreads();
    if (threadIdx.x == 0) {
        unsigned* bar = b.bar;
        __builtin_amdgcn_s_waitcnt(0);
        unsigned nloc = b.st[0], nx = b.st[1];
        if (nloc == 0u) { xcd_barrier_complete(bar, b.x, nloc, nx); b.st[0] = nloc; b.st[1] = nx; }
        const unsigned old = xb_add(&bar[XB_XSUB(b.x)], 1u);
        const unsigned gen = old / nloc;
        if (old + 1u == (gen + 1u) * nloc) {
            __builtin_amdgcn_fence(__ATOMIC_RELEASE, "agent");
            asm volatile("s_waitcnt vmcnt(0)" ::: "memory");
            const unsigned og = xb_add(&bar[XB_TOP], 1u);
            const unsigned tg = og / nx;
            if (og + 1u == (tg + 1u) * nx) xb_add(&bar[XB_TOPGEN], 1u);
            else XB_SPIN(xb_ld(&bar[XB_TOPGEN]) == tg, bar);
            __builtin_amdgcn_fence(__ATOMIC_ACQUIRE, "agent");
            xb_add(&bar[XB_XGEN(b.x)], 1u);
            asm volatile("s_waitcnt vmcnt(0)" ::: "memory");
        } else {
            XB_SPIN(xb_ld(&bar[XB_XGEN(b.x)]) == gen, bar);
            __builtin_amdgcn_fence(__ATOMIC_ACQUIRE, "agent");
            asm volatile("s_waitcnt vmcnt(0)" ::: "memory");
        }
    }
    __syncthreads();
}
namespace pr {
template <int CTRL> __device__ __forceinline__ float dpp_movf(float v) { return __builtin_bit_cast(float, __builtin_amdgcn_update_dpp(0, __builtin_bit_cast(int, v), CTRL, 0xf, 0xf, true)); }
__device__ __forceinline__ float wave_max_u(float v) {
    v = fmaxf(v, dpp_movf<0xB1>(v)); v = fmaxf(v, dpp_movf<0x4E>(v)); v = fmaxf(v, dpp_movf<0x141>(v)); v = fmaxf(v, dpp_movf<0x140>(v));
    const float a = __builtin_bit_cast(float, __builtin_amdgcn_readlane(__builtin_bit_cast(int, v), 0)), b = __builtin_bit_cast(float, __builtin_amdgcn_readlane(__builtin_bit_cast(int, v), 16)),
                c = __builtin_bit_cast(float, __builtin_amdgcn_readlane(__builtin_bit_cast(int, v), 32)), d = __builtin_bit_cast(float, __builtin_amdgcn_readlane(__builtin_bit_cast(int, v), 48));
    return fmaxf(fmaxf(a, b), fmaxf(c, d));
}
__device__ __forceinline__ float rstd_of(const float* __restrict__ ssq, int t, int lane) { return rsqrtf(wave_sum(ssq[t * 64 + lane]) * (1.f / DM) + EPS); }
__device__ __forceinline__ float gelu_erf(float a) { return 0.5f * a * (1.f + erff(a * 0.70710678118654752f)); }
typedef unsigned u32x4g __attribute__((ext_vector_type(4)));
__device__ __forceinline__ float sb2f(unsigned w, int b) { return (float)(signed char)((w >> (8 * b)) & 0xffu); }
__device__ __forceinline__ void gather_token8(int t, int lane, const bf16_t* __restrict__ XN2, const float* __restrict__ ssq, const int* __restrict__ EIDX, const float* __restrict__ GATE,
                                              const unsigned char* __restrict__ U8, const unsigned char* __restrict__ V8, const float* __restrict__ US, const float* __restrict__ VS, float* __restrict__ out) {
    const float rstd = rstd_of(ssq, t, lane);
    unsigned hq[4][4]; float hs;
    { float hv[4][16]; float am = 0.f;
#pragma unroll
      for (int i = 0; i < 4; ++i) { const u32x4g a = *(const u32x4g*)(XN2 + (size_t)t * DM + i * 1024 + lane * 16), b = *(const u32x4g*)(XN2 + (size_t)t * DM + i * 1024 + lane * 16 + 8);
#pragma unroll
          for (int e = 0; e < 4; ++e) { hv[i][2 * e] = __uint_as_float(a[e] << 16); hv[i][2 * e + 1] = __uint_as_float(a[e] & 0xffff0000u); hv[i][8 + 2 * e] = __uint_as_float(b[e] << 16); hv[i][8 + 2 * e + 1] = __uint_as_float(b[e] & 0xffff0000u); }
#pragma unroll
          for (int e = 0; e < 16; ++e) am = fmaxf(am, fabsf(hv[i][e])); }
      am = wave_max_u(am); hs = am * (1.f / 127.f); const float inv = am > 0.f ? 127.f / am : 0.f;
#pragma unroll
      for (int i = 0; i < 4; ++i)
#pragma unroll
          for (int w = 0; w < 4; ++w) { unsigned pk = 0;
#pragma unroll
              for (int b = 0; b < 4; ++b) pk |= ((unsigned)__float2int_rn(hv[i][4 * w + b] * inv) & 0xffu) << (8 * b);
              hq[i][w] = pk; } }
    const int e0 = EIDX[(size_t)t * PK + lane], e1 = EIDX[(size_t)t * PK + 64 + lane];
    const float g0 = GATE[(size_t)t * PK + lane], g1 = GATE[(size_t)t * PK + 64 + lane];
    const float su0 = US[e0], su1 = US[e1], sv0 = VS[e0], sv1 = VS[e1];
    int d0 = 0, d1 = 0;
#pragma unroll 2
    for (int k = 0; k < PK; ++k) {
        const int e = __builtin_amdgcn_readlane(k < 64 ? e0 : e1, k & 63);
        const unsigned char* row = U8 + (size_t)e * DM + lane * 16; int d = 0;
#pragma unroll
        for (int i = 0; i < 4; ++i) { const u32x4g u = *(const u32x4g*)(row + i * 1024);
#pragma unroll
            for (int w = 0; w < 4; ++w) d = __builtin_amdgcn_sdot4((int)u[w], (int)hq[i][w], d, false); }
#pragma unroll
        for (int o = 1; o < 64; o <<= 1) d += __shfl_xor(d, o);
        if (k < 64) d0 = (lane == k) ? d : d0; else d1 = (lane == (k & 63)) ? d : d1;
    }
    const float act0 = gelu_erf((float)d0 * su0 * hs * rstd) * g0 * sv0, act1 = gelu_erf((float)d1 * su1 * hs * rstd) * g1 * sv1;
    float acc[4][16];
#pragma unroll
    for (int i = 0; i < 4; ++i)
#pragma unroll
        for (int j = 0; j < 16; ++j) acc[i][j] = 0.f;
#pragma unroll 2
    for (int k = 0; k < PK; ++k) {
        const int e = __builtin_amdgcn_readlane(k < 64 ? e0 : e1, k & 63);
        const float a = __builtin_bit_cast(float, __builtin_amdgcn_readlane(__builtin_bit_cast(int, k < 64 ? act0 : act1), k & 63));
        const unsigned char* row = V8 + (size_t)e * DM + lane * 16;
#pragma unroll
        for (int i = 0; i < 4; ++i) { const u32x4g u = *(const u32x4g*)(row + i * 1024);
#pragma unroll
            for (int w = 0; w < 4; ++w)
#pragma unroll
                for (int b = 0; b < 4; ++b) acc[i][4 * w + b] += a * sb2f(u[w], b); }
    }
    float* orow = out + (size_t)t * DM + lane * 16;
#pragma unroll
    for (int i = 0; i < 4; ++i)
#pragma unroll
        for (int w = 0; w < 4; ++w) { float4 o = *(float4*)(orow + i * 1024 + 4 * w); o.x += acc[i][4 * w]; o.y += acc[i][4 * w + 1]; o.z += acc[i][4 * w + 2]; o.w += acc[i][4 * w + 3]; *(float4*)(orow + i * 1024 + 4 * w) = o; }
}
__device__ __forceinline__ void phase_gather8(const bf16_t* __restrict__ XN2, const float* __restrict__ ssq, const int* __restrict__ EIDX, const float* __restrict__ GATE,
                                              const unsigned char* __restrict__ U8, const unsigned char* __restrict__ V8, const float* __restrict__ US, const float* __restrict__ VS, float* __restrict__ out, int vcu, int G) {
    const int lane = threadIdx.x & 63, gw = vcu * 8 + (threadIdx.x >> 6), NGW = G * 8;
    for (int t = gw; t < S; t += NGW) gather_token8(t, lane, XN2, ssq, EIDX, GATE, U8, V8, US, VS, out);
}
__device__ __forceinline__ void tq_load(const float* __restrict__ pu, const float* __restrict__ pv, int row, int lane, float4 (&v)[16]) {
    const float* src = (row < NEXP ? pu + (size_t)row * DM : pv + (size_t)(row - NEXP) * DM) + lane * 16;
#pragma unroll
    for (int i = 0; i < 4; ++i)
#pragma unroll
        for (int w = 0; w < 4; ++w) v[4 * i + w] = *(const float4*)(src + i * 1024 + 4 * w);
}
__device__ __forceinline__ void tq_pack(unsigned char* __restrict__ T8, float* __restrict__ TS, int row, int lane, const float4 (&v)[16]) {
    float am = 0.f;
#pragma unroll
    for (int j = 0; j < 16; ++j) am = fmaxf(am, fmaxf(fmaxf(fabsf(v[j].x), fabsf(v[j].y)), fmaxf(fabsf(v[j].z), fabsf(v[j].w))));
    am = wave_max_u(am); const float inv = am > 0.f ? 127.f / am : 0.f;
#pragma unroll
    for (int i = 0; i < 4; ++i) { u32x4g o;
#pragma unroll
        for (int w = 0; w < 4; ++w) { const float4 x = v[4 * i + w]; o[w] = ((unsigned)__float2int_rn(x.x * inv) & 0xffu) | (((unsigned)__float2int_rn(x.y * inv) & 0xffu) << 8) | (((unsigned)__float2int_rn(x.z * inv) & 0xffu) << 16) | (((unsigned)__float2int_rn(x.w * inv) & 0xffu) << 24); }
        *(u32x4g*)(T8 + (size_t)row * DM + i * 1024 + lane * 16) = o; }
    if (lane == 0) TS[row] = am * (1.f / 127.f);
}
__device__ __forceinline__ void quant_tables(const float* __restrict__ pu, const float* __restrict__ pv, unsigned char* __restrict__ T8, float* __restrict__ TS, int gw, int NGW, int lane) {
    float4 va[16], vb[16]; int row = gw;
    if (row < 2 * NEXP) tq_load(pu, pv, row, lane, va);
    while (row < 2 * NEXP) { const int r1 = row + NGW, r2 = r1 + NGW;
        if (r1 < 2 * NEXP) tq_load(pu, pv, r1, lane, vb);
        tq_pack(T8, TS, row, lane, va);
        if (r1 >= 2 * NEXP) break;
        if (r2 < 2 * NEXP) tq_load(pu, pv, r2, lane, va);
        tq_pack(T8, TS, r1, lane, vb);
        row = r2; }
}
template <int CTRL> __device__ __forceinline__ int dpp_movi(int v) { return __builtin_amdgcn_update_dpp(0, v, CTRL, 0xf, 0xf, true); }
__device__ __forceinline__ int wave_sum_i_u(int v) {
    v += dpp_movi<0xB1>(v); v += dpp_movi<0x4E>(v); v += dpp_movi<0x141>(v); v += dpp_movi<0x140>(v);
    return __builtin_amdgcn_readlane(v, 0) + __builtin_amdgcn_readlane(v, 16) + __builtin_amdgcn_readlane(v, 32) + __builtin_amdgcn_readlane(v, 48);
}
__device__ __forceinline__ void quant_tokens(const bf16_t* __restrict__ XN2, unsigned char* __restrict__ H8, float* __restrict__ HS, int gw, int NGW, int lane) {
    u32x4g na_[4], nb_[4];
    if (gw < S) {
#pragma unroll
        for (int i = 0; i < 4; ++i) { na_[i] = *(const u32x4g*)(XN2 + (size_t)gw * DM + i * 1024 + lane * 16); nb_[i] = *(const u32x4g*)(XN2 + (size_t)gw * DM + i * 1024 + lane * 16 + 8); } }
    for (int t = gw; t < S; t += NGW) {
        float hv[4][16]; float am = 0.f;
#pragma unroll
        for (int i = 0; i < 4; ++i) { const u32x4g a = na_[i], b = nb_[i];
#pragma unroll
            for (int e = 0; e < 4; ++e) { hv[i][2 * e] = __uint_as_float(a[e] << 16); hv[i][2 * e + 1] = __uint_as_float(a[e] & 0xffff0000u); hv[i][8 + 2 * e] = __uint_as_float(b[e] << 16); hv[i][8 + 2 * e + 1] = __uint_as_float(b[e] & 0xffff0000u); }
#pragma unroll
            for (int e = 0; e < 16; ++e) am = fmaxf(am, fabsf(hv[i][e])); }
        if (t + NGW < S) {
#pragma unroll
            for (int i = 0; i < 4; ++i) { na_[i] = *(const u32x4g*)(XN2 + (size_t)(t + NGW) * DM + i * 1024 + lane * 16); nb_[i] = *(const u32x4g*)(XN2 + (size_t)(t + NGW) * DM + i * 1024 + lane * 16 + 8); } }
        am = wave_max_u(am); const float inv = am > 0.f ? 127.f / am : 0.f;
#pragma unroll
        for (int i = 0; i < 4; ++i) { u32x4g o;
#pragma unroll
            for (int w = 0; w < 4; ++w) { unsigned pk = 0;
#pragma unroll
                for (int b = 0; b < 4; ++b) pk |= ((unsigned)__float2int_rn(hv[i][4 * w + b] * inv) & 0xffu) << (8 * b);
                o[w] = pk; }
            *(u32x4g*)(H8 + (size_t)t * DM + i * 1024 + lane * 16) = o; }
        if (lane == 0) HS[t] = am * (1.f / 127.f);
    }
}
__device__ __forceinline__ void phase_udot(const unsigned char* __restrict__ H8, const int* __restrict__ EIDX, const unsigned char* __restrict__ U8, int* __restrict__ D, int bx, int G) {
    const int lane = threadIdx.x & 63, w = __builtin_amdgcn_readfirstlane(threadIdx.x >> 6), p = bx & 7, r = bx >> 3, R = G >> 3;
    for (int tg = r; tg < S / 64; tg += R) {
        const int tb = tg * 64 + 8 * w;
        unsigned hq[8][4][4]; int e0[8], e1[8];
#pragma unroll
        for (int i = 0; i < 8; ++i) {
#pragma unroll
            for (int j = 0; j < 4; ++j) { const u32x4g v = *(const u32x4g*)(H8 + (size_t)(tb + i) * DM + j * 1024 + lane * 16); hq[i][j][0] = v[0]; hq[i][j][1] = v[1]; hq[i][j][2] = v[2]; hq[i][j][3] = v[3]; }
            e0[i] = EIDX[(size_t)(tb + i) * PK + lane]; e1[i] = EIDX[(size_t)(tb + i) * PK + 64 + lane]; }
#pragma unroll 1
        for (int s = 0; s < 4; ++s) { const int part = p * 4 + s;
#pragma unroll
            for (int i = 0; i < 8; ++i) {
#pragma unroll
                for (int hf = 0; hf < 2; ++hf) { const int ev = hf ? e1[i] : e0[i];
                    unsigned long long bm = __ballot((ev >> 9) == part);
                    while (bm) {
                        const int k0 = __ffsll((long long)bm) - 1; bm &= bm - 1; const bool two = bm != 0ull; const int k1 = two ? __ffsll((long long)bm) - 1 : k0; bm &= bm - 1;
                        const unsigned char* ra = U8 + (size_t)__builtin_amdgcn_readlane(ev, k0) * DM + lane * 16; const unsigned char* rb = U8 + (size_t)__builtin_amdgcn_readlane(ev, k1) * DM + lane * 16;
                        u32x4g ua[4], ub[4];
#pragma unroll
                        for (int j = 0; j < 4; ++j) { ua[j] = *(const u32x4g*)(ra + j * 1024); ub[j] = *(const u32x4g*)(rb + j * 1024); }
                        int da = 0, db = 0;
#pragma unroll
                        for (int j = 0; j < 4; ++j)
#pragma unroll
                            for (int q = 0; q < 4; ++q) { da = __builtin_amdgcn_sdot4((int)ua[j][q], (int)hq[i][j][q], da, false); db = __builtin_amdgcn_sdot4((int)ub[j][q], (int)hq[i][j][q], db, false); }
                        da = wave_sum_i_u(da); db = wave_sum_i_u(db);
                        if (lane == 0) { D[(size_t)(tb + i) * PK + hf * 64 + k0] = da; D[(size_t)(tb + i) * PK + hf * 64 + k1] = db; } } } } }
    }
}
#define VS_TAKE(E, C, HAS) int E = 0, C = 0; bool HAS = false;     \
        if (bm0_) { const int k_ = __ffsll((long long)bm0_) - 1; bm0_ &= bm0_ - 1; const int w_ = __builtin_amdgcn_readlane(E0v_, k_); E = w_ & 0xffff; C = w_ >> 16; HAS = true; } \
        else if (bm1_) { const int k_ = __ffsll((long long)bm1_) - 1; bm1_ &= bm1_ - 1; const int w_ = __builtin_amdgcn_readlane(E1v_, k_); E = w_ & 0xffff; C = w_ >> 16; HAS = true; }
#define VS_MAC4(ACC) _Pragma("unroll") for (int i_ = 0; i_ < 2; ++i_) _Pragma("unroll") for (int w_ = 0; w_ < 4; ++w_) { \
                const unsigned ablo_ = __builtin_amdgcn_perm(xb_[i_][w_], xa_[i_][w_], 0x05010400u), abhi_ = __builtin_amdgcn_perm(xb_[i_][w_], xa_[i_][w_], 0x07030602u); \
                const unsigned cdlo_ = __builtin_amdgcn_perm(xd_[i_][w_], xc_[i_][w_], 0x05010400u), cdhi_ = __builtin_amdgcn_perm(xd_[i_][w_], xc_[i_][w_], 0x07030602u); \
                ACC[i_][4 * w_ + 0] = __builtin_amdgcn_sdot4((int)__builtin_amdgcn_perm(cdlo_, ablo_, 0x05040100u), coef_, ACC[i_][4 * w_ + 0], false); \
                ACC[i_][4 * w_ + 1] = __builtin_amdgcn_sdot4((int)__builtin_amdgcn_perm(cdlo_, ablo_, 0x07060302u), coef_, ACC[i_][4 * w_ + 1], false); \
                ACC[i_][4 * w_ + 2] = __builtin_amdgcn_sdot4((int)__builtin_amdgcn_perm(cdhi_, abhi_, 0x05040100u), coef_, ACC[i_][4 * w_ + 2], false); \
                ACC[i_][4 * w_ + 3] = __builtin_amdgcn_sdot4((int)__builtin_amdgcn_perm(cdhi_, abhi_, 0x07060302u), coef_, ACC[i_][4 * w_ + 3], false); }
#define VS_ROWS4F(ACC, E0, E1, P0, P1) do { const int E0v_ = (E0), E1v_ = (E1); \
          \
        const unsigned long long av0_ = __ballot(((E0v_ >> 10) & 63) <= s) & (P0), av1_ = __ballot(((E1v_ >> 10) & 63) <= s) & (P1); unsigned long long bm0_ = av0_, bm1_ = av1_; \
        for (int nt_ = (__builtin_popcountll(av0_) + __builtin_popcountll(av1_)) >> 2; nt_ > 0; --nt_) { VS_TAKE(ea_, ca_, ha_) VS_TAKE(eb_, cb_, hb_) VS_TAKE(ec_, cc_, hc_) VS_TAKE(ed_, cd_, hd_)     \
            const int coef_ = (ca_ & 255) | ((cb_ & 255) << 8) | ((cc_ & 255) << 16) | (cd_ << 24); \
            u32x4g xa_[2], xb_[2], xc_[2], xd_[2]; \
            { const unsigned char* r_ = vsb + (size_t)ea_ * DM + l16; _Pragma("unroll") for (int i_ = 0; i_ < 2; ++i_) xa_[i_] = *(const u32x4g*)(r_ + i_ * 1024); } \
            { const unsigned char* r_ = vsb + (size_t)eb_ * DM + l16; _Pragma("unroll") for (int i_ = 0; i_ < 2; ++i_) xb_[i_] = *(const u32x4g*)(r_ + i_ * 1024); } \
            { const unsigned char* r_ = vsb + (size_t)ec_ * DM + l16; _Pragma("unroll") for (int i_ = 0; i_ < 2; ++i_) xc_[i_] = *(const u32x4g*)(r_ + i_ * 1024); } \
            { const unsigned char* r_ = vsb + (size_t)ed_ * DM + l16; _Pragma("unroll") for (int i_ = 0; i_ < 2; ++i_) xd_[i_] = *(const u32x4g*)(r_ + i_ * 1024); } \
            VS_MAC4(ACC) } \
        (P0) ^= av0_ ^ bm0_; (P1) ^= av1_ ^ bm1_; } while (0)
#define VS_ROWS4L(ACC, E0, E1, P0, P1) do { const int E0v_ = (E0), E1v_ = (E1);     \
        unsigned long long bm0_ = (P0), bm1_ = (P1); \
        while (bm0_ | bm1_) { VS_TAKE(ea_, ca_, ha_) VS_TAKE(eb_, cb_, hb_) VS_TAKE(ec_, cc_, hc_) VS_TAKE(ed_, cd_, hd_) \
            const int coef_ = (ca_ & 255) | ((cb_ & 255) << 8) | ((cc_ & 255) << 16) | (cd_ << 24); \
            u32x4g xa_[2], xb_[2], xc_[2], xd_[2]; \
            _Pragma("unroll") for (int i_ = 0; i_ < 2; ++i_) { xa_[i_] = (u32x4g){0u, 0u, 0u, 0u}; xb_[i_] = xa_[i_]; xc_[i_] = xa_[i_]; xd_[i_] = xa_[i_]; } \
            { const unsigned char* r_ = vsb + (size_t)ea_ * DM + l16; _Pragma("unroll") for (int i_ = 0; i_ < 2; ++i_) xa_[i_] = *(const u32x4g*)(r_ + i_ * 1024); } \
            if (hb_) { const unsigned char* r_ = vsb + (size_t)eb_ * DM + l16; _Pragma("unroll") for (int i_ = 0; i_ < 2; ++i_) xb_[i_] = *(const u32x4g*)(r_ + i_ * 1024); } \
            if (hc_) { const unsigned char* r_ = vsb + (size_t)ec_ * DM + l16; _Pragma("unroll") for (int i_ = 0; i_ < 2; ++i_) xc_[i_] = *(const u32x4g*)(r_ + i_ * 1024); } \
            if (hd_) { const unsigned char* r_ = vsb + (size_t)ed_ * DM + l16; _Pragma("unroll") for (int i_ = 0; i_ < 2; ++i_) xd_[i_] = *(const u32x4g*)(r_ + i_ * 1024); } \
            VS_MAC4(ACC) } } while (0)
#define VS_TOKEN(X, t) const float rs##X = rstd_of(ssq, t, lane) * HS[t]; const int e##X##0 = EIDX[(size_t)(t) * PK + lane], e##X##1 = EIDX[(size_t)(t) * PK + 64 + lane]; \
        const float a##X##0 = gelu_erf((float)D[(size_t)(t) * PK + lane] * US[e##X##0] * rs##X) * GATE[(size_t)(t) * PK + lane] * VS[e##X##0], a##X##1 = gelu_erf((float)D[(size_t)(t) * PK + 64 + lane] * US[e##X##1] * rs##X) * GATE[(size_t)(t) * PK + 64 + lane] * VS[e##X##1]; \
        const float m##X = wave_max(fmaxf(fabsf(a##X##0), fabsf(a##X##1))); const float i##X = m##X > 0.f ? 127.f / m##X : 0.f; const int c##X##0 = __float2int_rn(a##X##0 * i##X), c##X##1 = __float2int_rn(a##X##1 * i##X);
#define VS_STORE(ACC, X, t) do { const float sc_ = m##X * (1.f / 127.f); float* o_ = out + (size_t)(t) * DM + ph * 2048 + lane * 16; \
        _Pragma("unroll") for (int i_ = 0; i_ < 2; ++i_) _Pragma("unroll") for (int w_ = 0; w_ < 4; ++w_) { float4 q_ = *(float4*)(o_ + i_ * 1024 + 4 * w_); \
            q_.x += sc_ * (float)ACC[i_][4 * w_]; q_.y += sc_ * (float)ACC[i_][4 * w_ + 1]; q_.z += sc_ * (float)ACC[i_][4 * w_ + 2]; q_.w += sc_ * (float)ACC[i_][4 * w_ + 3]; *(float4*)(o_ + i_ * 1024 + 4 * w_) = q_; } } while (0)
__device__ __forceinline__ void phase_vsum2(const int* __restrict__ D, const float* __restrict__ HS, const float* __restrict__ ssq, const int* __restrict__ EIDX, const float* __restrict__ GATE,
                                            const unsigned char* __restrict__ V8, const float* __restrict__ US, const float* __restrict__ VS, float* __restrict__ out, int vcu, int G) {
    const int lane = threadIdx.x & 63, gw = vcu * 8 + __builtin_amdgcn_readfirstlane(threadIdx.x >> 6), NGW = G * 8;
    for (int t0 = 4 * gw; t0 < S; t0 += 4 * NGW) {
        VS_TOKEN(A, t0) VS_TOKEN(B, t0 + 1) VS_TOKEN(C, t0 + 2) VS_TOKEN(E, t0 + 3)
        const int kA0 = eA0 | (cA0 << 16), kA1 = eA1 | (cA1 << 16), kB0 = eB0 | (cB0 << 16), kB1 = eB1 | (cB1 << 16), kC0 = eC0 | (cC0 << 16), kC1 = eC1 | (cC1 << 16), kE0 = eE0 | (cE0 << 16), kE1 = eE1 | (cE1 << 16);
#pragma unroll 1
        for (int ph = 0; ph < 2; ++ph) { const unsigned char* vsb = V8 + ph * 2048; const unsigned l16 = lane * 16;
            int accA[2][16], accB[2][16], accC[2][16], accE[2][16];
#pragma unroll
            for (int i = 0; i < 2; ++i)
#pragma unroll
                for (int j = 0; j < 16; ++j) { accA[i][j] = 0; accB[i][j] = 0; accC[i][j] = 0; accE[i][j] = 0; }
            unsigned long long pA0 = ~0ull, pA1 = ~0ull, pB0 = ~0ull, pB1 = ~0ull, pC0 = ~0ull, pC1 = ~0ull, pE0 = ~0ull, pE1 = ~0ull;
#pragma unroll 1
            for (int s = 0; s < NEXP / 1024 - 1; ++s) { VS_ROWS4F(accA, kA0, kA1, pA0, pA1); VS_ROWS4F(accB, kB0, kB1, pB0, pB1); VS_ROWS4F(accC, kC0, kC1, pC0, pC1); VS_ROWS4F(accE, kE0, kE1, pE0, pE1); }
            VS_ROWS4L(accA, kA0, kA1, pA0, pA1); VS_ROWS4L(accB, kB0, kB1, pB0, pB1); VS_ROWS4L(accC, kC0, kC1, pC0, pC1); VS_ROWS4L(accE, kE0, kE1, pE0, pE1);
            VS_STORE(accA, A, t0); VS_STORE(accB, B, t0 + 1); VS_STORE(accC, C, t0 + 2); VS_STORE(accE, E, t0 + 3);
        }
    }
}
}
namespace pg8 {
#define PG8_LAS __attribute__((address_space(3)))
typedef short bf16x8 __attribute__((ext_vector_type(8)));
typedef float f32x4 __attribute__((ext_vector_type(4)));
typedef unsigned u32x4 __attribute__((ext_vector_type(4)));
typedef unsigned u32x2 __attribute__((ext_vector_type(2)));
#ifndef G1_WGM
#define G1_WGM 8
#endif
constexpr int BM = 256, BK = 64, HALF = 128, HTB = HALF * BK * 2, STAGE_BYTES = 8 * HTB, NXCD = 8, WGM = 8;
__device__ __forceinline__ int lds_byte(int r, int c) { const int st = (r >> 4) * 2 + (c >> 5), rr = r & 15, cc = c & 31, ob = rr * 64 + cc * 2; return st * 1024 + (ob ^ (((ob >> 9) & 1) << 5)); }
__device__ __forceinline__ void stage_rc(int b, int& R, int& C) { const int st = b / 1024, sb = b % 1024, swz = sb ^ (((sb >> 9) & 1) << 5); R = (st >> 1) * 16 + swz / 64; C = (st & 1) * 32 + (swz % 64) / 2; }
__device__ __forceinline__ int perm32(int rho) { const int n = rho >> 4, i = rho & 15; return 8 * (i >> 2) + 4 * n + (i & 3); }
typedef __bf16 bf16x2_t __attribute__((ext_vector_type(2)));
typedef float f32x2_t __attribute__((ext_vector_type(2)));
__device__ __forceinline__ unsigned cvt_pk_bf16(float lo, float hi) { return __builtin_bit_cast(unsigned, __builtin_convertvector((f32x2_t){lo, hi}, bf16x2_t)); }

struct Tile { const char* A; const char* B; int nt, pm, pn, kind, seq; };
template <int WGMT = WGM> __device__ __forceinline__ void static_order(int L, int nM, int nN, int& pm, int& pn) {
    const int nwg = nM * nN; int wgid = L; { const int q = nwg / NXCD, r = nwg % NXCD, xcd = wgid % NXCD, off = wgid / NXCD; wgid = (xcd < r ? xcd * (q + 1) : r * (q + 1) + (xcd - r) * q) + off; }
    const int nig = WGMT * nN, gid = wgid / nig, fm = gid * WGMT, gsz = (nM - fm) < WGMT ? (nM - fm) : WGMT;
    pm = fm + ((wgid % nig) % gsz); pn = (wgid % nig) / gsz;
}
typedef int i32x4 __attribute__((ext_vector_type(4)));
template <bool I8> __device__ __forceinline__ f32x4 mma16(bf16x8 b, bf16x8 a, f32x4 c) {
    if constexpr (I8) return __builtin_bit_cast(f32x4, __builtin_amdgcn_mfma_i32_16x16x64_i8(__builtin_bit_cast(i32x4, b), __builtin_bit_cast(i32x4, a), __builtin_bit_cast(i32x4, c), 0, 0, 0));
    else return __builtin_amdgcn_mfma_f32_16x16x32_bf16(b, a, c, 0, 0, 0);
}
template <class Epi, class Sched, bool I8 = false>
__device__ __forceinline__ void gemm_phase(PG8_LAS unsigned char* lds, const Sched& S, const Epi& E) {
    const int tid = threadIdx.x, wid = __builtin_amdgcn_readfirstlane(tid >> 6), lane = tid & 63, wr = wid >> 2, wc = wid & 3, fr = lane & 15, fq = lane >> 4;
    unsigned voffA[2], voffB[2];
#pragma unroll
    for (int i = 0; i < 2; ++i) { int R, C; stage_rc(tid * 16 + i * 8192, R, C); const int Rb = (R & ~31) + perm32(R & 31); voffA[i] = (unsigned)R * S.pa + C * 2; voffB[i] = (unsigned)Rb * S.pb + C * 2; }
    const size_t kstep = (size_t)(BK * 2);
    const size_t hsA = (size_t)HALF * S.pa, hsB = (size_t)HALF * S.pb;
    const unsigned ldsw = (unsigned)wid * 1024u;
    const int aoff = lds_byte(wr * 64 + fr, fq * 8), boff = lds_byte(wc * 32 + fr, fq * 8);
#define PG8_SA(b, h) (((b) * 2 + (h)) * HTB)
#define PG8_SB(b, h) ((4 + (b) * 2 + (h)) * HTB)
#define PG8_STAGE(bufoff, gbase, voff) do { _Pragma("unroll") for (int _i = 0; _i < 2; ++_i) \
        __builtin_amdgcn_global_load_lds((const unsigned*)((const char*)(gbase) + (voff)[_i]), (PG8_LAS unsigned*)(lds + (bufoff) + ldsw + _i * 8192), 16, 0, 0); } while (0)
#define PG8_LDA(dst, b, h) do { _Pragma("unroll") for (int m = 0; m < 4; ++m) _Pragma("unroll") for (int k = 0; k < 2; ++k) dst[m][k] = *(const PG8_LAS bf16x8*)(lds + PG8_SA(b, h) + aoff + m * 2048 + k * 1024); } while (0)
#define PG8_LDB(dst, b, h) do { _Pragma("unroll") for (int n = 0; n < 2; ++n) _Pragma("unroll") for (int k = 0; k < 2; ++k) dst[n][k] = *(const PG8_LAS bf16x8*)(lds + PG8_SB(b, h) + boff + n * 2048 + k * 1024); } while (0)
#define PG8_MMA(ai, bj, At, Bt) do { __builtin_amdgcn_s_setprio(1); _Pragma("unroll") for (int m = 0; m < 4; ++m) _Pragma("unroll") for (int n = 0; n < 2; ++n) _Pragma("unroll") for (int k = 0; k < 2; ++k) \
        acc[ai][bj][m][n] = mma16<I8>(Bt[n][k], At[m][k], acc[ai][bj][m][n]); __builtin_amdgcn_s_setprio(0); } while (0)
#define PG8_WAIT_V(n) asm volatile("s_waitcnt vmcnt(" #n ")" ::: "memory")
#define PG8_WAIT_L(n) asm volatile("s_waitcnt lgkmcnt(" #n ")" ::: "memory")
#define PG8_BAR __builtin_amdgcn_s_barrier()
#define PG8_SCHED __builtin_amdgcn_sched_barrier(0)
    Tile cur, nxt; int ui = 0;
    if (!S.next(0, cur)) return;
    f32x4 acc[2][2][4][2];
#pragma unroll
    for (int a = 0; a < 2; ++a)
#pragma unroll
        for (int b = 0; b < 2; ++b)
#pragma unroll
            for (int m = 0; m < 4; ++m)
#pragma unroll
                for (int n = 0; n < 2; ++n) acc[a][b][m][n] = (f32x4){0.f, 0.f, 0.f, 0.f};
    bf16x8 At[4][2], B0[2][2], B1[2][2];
    const char* cA = cur.A; const char* cB = cur.B;
    PG8_STAGE(PG8_SB(0, 0), cB, voffB); PG8_STAGE(PG8_SA(0, 0), cA, voffA); PG8_STAGE(PG8_SB(0, 1), cB + hsB, voffB); PG8_STAGE(PG8_SA(0, 1), cA + hsA, voffA);
    if (wr == 1) PG8_BAR;
    PG8_WAIT_V(4); PG8_BAR;
    PG8_STAGE(PG8_SB(1, 0), cB + kstep, voffB); PG8_STAGE(PG8_SA(1, 0), cA + kstep, voffA); PG8_STAGE(PG8_SB(1, 1), cB + hsB + kstep, voffB);
    PG8_WAIT_V(6); PG8_BAR;
    for (;;) {
        const bool has_next = S.next(ui + 1, nxt);
        const char* nA = has_next ? nxt.A : cA; const char* nB = has_next ? nxt.B : cB;
        const int nt = cur.nt;
        for (int t = 0; t < nt; t += 2) {
            const bool last = (t == nt - 2);
            const char* a1 = cA + (size_t)(t + 1) * kstep;
            const char* a2 = last ? nA : cA + (size_t)(t + 2) * kstep; const char* b2 = last ? nB : cB + (size_t)(t + 2) * kstep;
            const char* a3 = a2 + kstep; const char* b3 = b2 + kstep;
            PG8_LDB(B0, 0, 0); PG8_SCHED; PG8_LDA(At, 0, 0); PG8_STAGE(PG8_SA(1, 1), a1 + hsA, voffA);
            PG8_WAIT_L(8); PG8_BAR; PG8_WAIT_L(0); PG8_MMA(0, 0, At, B0); PG8_BAR; PG8_SCHED;
            PG8_LDB(B1, 0, 1); PG8_STAGE(PG8_SB(0, 0), b2, voffB);
            PG8_BAR; PG8_WAIT_L(0); PG8_MMA(0, 1, At, B1); PG8_BAR;
            PG8_LDA(At, 0, 1); PG8_STAGE(PG8_SA(0, 0), a2, voffA);
            PG8_BAR; PG8_WAIT_L(0); PG8_MMA(1, 0, At, B0); PG8_BAR; PG8_SCHED;
            PG8_STAGE(PG8_SB(0, 1), b2 + hsB, voffB);
            PG8_WAIT_V(6); PG8_BAR; PG8_MMA(1, 1, At, B1); PG8_BAR;
            PG8_LDB(B0, 1, 0); PG8_SCHED; PG8_LDA(At, 1, 0); PG8_STAGE(PG8_SA(0, 1), a2 + hsA, voffA);
            PG8_WAIT_L(8); PG8_BAR; PG8_WAIT_L(0); PG8_MMA(0, 0, At, B0); PG8_BAR; PG8_SCHED;
            PG8_LDB(B1, 1, 1); PG8_STAGE(PG8_SB(1, 0), b3, voffB);
            PG8_BAR; PG8_WAIT_L(0); PG8_MMA(0, 1, At, B1); PG8_BAR;
            PG8_LDA(At, 1, 1); PG8_STAGE(PG8_SA(1, 0), a3, voffA);
            PG8_BAR; PG8_WAIT_L(0); PG8_MMA(1, 0, At, B0); PG8_BAR; PG8_SCHED;
            PG8_STAGE(PG8_SB(1, 1), b3 + hsB, voffB);
            PG8_WAIT_V(6); PG8_BAR; PG8_MMA(1, 1, At, B1); PG8_BAR;
        }
        const bool keep = E(acc, cur, wr, wc, fr, fq, lds + STAGE_BYTES);
        if (!has_next) break;
        if (!keep) {
#pragma unroll
            for (int a = 0; a < 2; ++a)
#pragma unroll
                for (int b = 0; b < 2; ++b)
#pragma unroll
                    for (int m = 0; m < 4; ++m)
#pragma unroll
                        for (int n = 0; n < 2; ++n) acc[a][b][m][n] = (f32x4){0.f, 0.f, 0.f, 0.f};
        }
        cur = nxt; cA = nA; cB = nB; ++ui;
    }
    PG8_WAIT_V(0);
    if (wr == 0) PG8_BAR;
    PG8_BAR;
#undef PG8_SA
#undef PG8_SB
#undef PG8_STAGE
#undef PG8_LDA
#undef PG8_LDB
#undef PG8_MMA
}
#define EPI_BAR() do { asm volatile("s_waitcnt lgkmcnt(0)" ::: "memory"); __builtin_amdgcn_s_barrier(); asm volatile("" ::: "memory"); } while (0)

struct Epi1 {
    unsigned char* ws; const float *XS, *WS8; const float *gqa, *gka, *gqb, *gkb;
    __device__ __forceinline__ bool operator()(f32x4 (&acc)[2][2][4][2], const Tile& u, int wr, int wc, int fr, int fq, PG8_LAS unsigned char* scr) const {
        const int pn = u.pn; size_t boff; int W, ct; const float* gain; float sc = 1.f;
        if (pn < 9) { boff = WS_QA; W = WA; ct = pn; gain = gqa; sc = QSCALE; } else if (pn < 18) { boff = WS_KA; W = WA; ct = pn - 9; gain = gka; }
        else if (pn < 25) { boff = WS_QB; W = WB; ct = pn - 18; gain = gqb; sc = QSCALE; } else { boff = WS_KB; W = WB; ct = pn - 25; gain = gkb; }
        bf16_t* const O = (bf16_t*)(ws + boff);
        const int col0 = ct * 256 + 32 * wc + 8 * fq;
        { const float* wsp = WS8 + pn * 256 + 32 * wc + 8 * fq; f32x4 wsc[2][2]; float xs[2][4];
#pragma unroll
          for (int bj = 0; bj < 2; ++bj) { wsc[bj][0] = *(const f32x4*)(wsp + bj * 128); wsc[bj][1] = *(const f32x4*)(wsp + bj * 128 + 4); }
#pragma unroll
          for (int ai = 0; ai < 2; ++ai)
#pragma unroll
              for (int m = 0; m < 4; ++m) xs[ai][m] = XS[u.pm * 256 + ai * 128 + wr * 64 + m * 16 + fr];
#pragma unroll
          for (int ai = 0; ai < 2; ++ai)
#pragma unroll
              for (int m = 0; m < 4; ++m)
#pragma unroll
                  for (int bj = 0; bj < 2; ++bj)
#pragma unroll
                      for (int h = 0; h < 2; ++h) { const i32x4 a = __builtin_bit_cast(i32x4, acc[ai][bj][m][h]);
#pragma unroll
                          for (int e = 0; e < 4; ++e) acc[ai][bj][m][h][e] = (float)a[e] * xs[ai][m] * wsc[bj][h][e]; } }
        PG8_LAS float* P = (PG8_LAS float*)scr;
#pragma unroll
        for (int ai = 0; ai < 2; ++ai)
#pragma unroll
            for (int m = 0; m < 4; ++m)
#pragma unroll
                for (int bj = 0; bj < 2; ++bj) { const f32x4 a = acc[ai][bj][m][0], b = acc[ai][bj][m][1];
                    float s = (a[0] * a[0] + a[1] * a[1]) + (a[2] * a[2] + a[3] * a[3]) + (b[0] * b[0] + b[1] * b[1]) + (b[2] * b[2] + b[3] * b[3]);
                    s += __shfl_xor(s, 16); s += __shfl_xor(s, 32);
                    if (fq == 0) P[((ai * 128 + wr * 64 + m * 16 + fr) * 2 + bj) * 4 + wc] = s; }
        EPI_BAR();
        const f32x4 g0 = *(const f32x4*)(gain + 32 * wc + 8 * fq) * sc, g1 = *(const f32x4*)(gain + 32 * wc + 8 * fq + 4) * sc;
#pragma unroll
        for (int ai = 0; ai < 2; ++ai)
#pragma unroll
            for (int m = 0; m < 4; ++m) { const int r = ai * 128 + wr * 64 + m * 16 + fr; bf16_t* rowp = O + (size_t)(u.pm * 256 + r) * W + col0;
#pragma unroll
                for (int bj = 0; bj < 2; ++bj) { const f32x4 p = *(const PG8_LAS f32x4*)(P + (r * 2 + bj) * 4);
                    const float rstd = rsqrtf(((p[0] + p[1]) + (p[2] + p[3])) * (1.f / HD) + EPS);
                    const f32x4 v0 = acc[ai][bj][m][0] * rstd * g0, v1 = acc[ai][bj][m][1] * rstd * g1;
                    u32x4 w; w.x = cvt_pk_bf16(v0[0], v0[1]); w.y = cvt_pk_bf16(v0[2], v0[3]); w.z = cvt_pk_bf16(v1[0], v1[1]); w.w = cvt_pk_bf16(v1[2], v1[3]);
                    *(u32x4*)(rowp + bj * 128) = w; } }
        return false;
    }
};
struct Sched1 {
    const char* XN; const char* W; int G, c, nN, nt; unsigned pa, pb;
    __device__ __forceinline__ bool next(int i, Tile& u) const {
        const int L = i * G + c; if (L >= 32 * nN) return false;
        int pm, pn; static_order<G1_WGM>(L, 32, nN, pm, pn); u.seq = L;
        u.nt = nt; u.pm = pm; u.pn = pn; u.A = XN + (size_t)pm * 256 * pa; u.B = W + (size_t)pn * 256 * pb;
        u.kind = 0;
        return true;
    }
};
struct EpiGate8 {
    unsigned char* ws; const float *XS, *WS8;
    __device__ __forceinline__ bool operator()(f32x4 (&acc)[2][2][4][2], const Tile& u, int wr, int wc, int fr, int fq, PG8_LAS unsigned char*) const {
        const int pn = u.pn; const bool sig = pn >= 16; int W, ct; size_t boff;
        if (pn < 9) { W = WA * 2; ct = pn; boff = WS_VAN; } else if (pn < 16) { W = WB * 2; ct = pn - 9; boff = WS_VBN; } else if (pn < 32) { W = DM; ct = pn - 16; boff = WS_GA; } else { W = DM; ct = pn - 32; boff = WS_GB; }
        unsigned char* const obase = ws + boff;
        const int col0 = ct * 256 + 32 * wc + 8 * fq; const float* wsp = WS8 + pn * 256 + 32 * wc + 8 * fq; const float fac = sig ? -LOG2E : 1.f; const float lo8 = pn >= 32 ? 1.f : 0.f;
        f32x4 wsc[2][2];
#pragma unroll
        for (int bj = 0; bj < 2; ++bj) { wsc[bj][0] = *(const f32x4*)(wsp + bj * 128) * fac; wsc[bj][1] = *(const f32x4*)(wsp + bj * 128 + 4) * fac; }
        float xsv[2][4];
#pragma unroll
        for (int ai = 0; ai < 2; ++ai)
#pragma unroll
            for (int m = 0; m < 4; ++m) xsv[ai][m] = XS[u.pm * 256 + ai * 128 + wr * 64 + m * 16 + fr];
        asm volatile("" ::: "memory");
#pragma unroll
        for (int ai = 0; ai < 2; ++ai)
#pragma unroll
            for (int m = 0; m < 4; ++m) { const int row = u.pm * 256 + ai * 128 + wr * 64 + m * 16 + fr; const float xs = xsv[ai][m];
#pragma unroll
                for (int bj = 0; bj < 2; ++bj) { const i32x4 a0 = __builtin_bit_cast(i32x4, acc[ai][bj][m][0]), a1 = __builtin_bit_cast(i32x4, acc[ai][bj][m][1]); f32x4 v0, v1;
#pragma unroll
                    for (int e = 0; e < 4; ++e) { v0[e] = (float)a0[e] * xs * wsc[bj][0][e]; v1[e] = (float)a1[e] * xs * wsc[bj][1][e]; }
                    if (sig) { unsigned lo = 0, hi = 0;
#pragma unroll
                        for (int e = 0; e < 4; ++e) { const float s0 = fmaxf(255.f * __builtin_amdgcn_rcpf(1.f + __builtin_amdgcn_exp2f(v0[e])), lo8), s1 = fmaxf(255.f * __builtin_amdgcn_rcpf(1.f + __builtin_amdgcn_exp2f(v1[e])), lo8);
                            lo |= (unsigned)__float2int_rn(s0) << (8 * e); hi |= (unsigned)__float2int_rn(s1) << (8 * e); }
                        *(u32x2*)(obase + (size_t)row * W + col0 + bj * 128) = (u32x2){lo, hi};
                    } else { bf16_t* rowp = (bf16_t*)(obase + (size_t)row * W) + col0;
                        u32x4 w; w.x = cvt_pk_bf16(v0[0], v0[1]); w.y = cvt_pk_bf16(v0[2], v0[3]); w.z = cvt_pk_bf16(v1[0], v1[1]); w.w = cvt_pk_bf16(v1[2], v1[3]);
                        *(u32x4*)(rowp + bj * 128) = w; } } }
        return false;
    }
};
__device__ __forceinline__ float ub2f(unsigned w, int b) { return (float)((w >> (8 * b)) & 255u); }
struct EpiUp {
    const unsigned char *GA, *GB; bf16_t* MG;
    __device__ __forceinline__ bool operator()(f32x4 (&acc)[2][2][4][2], const Tile& u, int wr, int wc, int fr, int fq, PG8_LAS unsigned char*) const {
        const int col0 = u.pn * 256 + 32 * wc + 8 * fq; const size_t ro0 = (size_t)(u.pm * 256 + wr * 64 + fr) * DM + col0;
        if (u.kind == 0) {
#pragma unroll
            for (int ai = 0; ai < 2; ++ai) {
                u32x2 gav[4][2], gbv[4][2];
#pragma unroll
                for (int m = 0; m < 4; ++m)
#pragma unroll
                    for (int bj = 0; bj < 2; ++bj) { gav[m][bj] = *(const u32x2*)(GA + ro0 + (size_t)(ai * 128 + m * 16) * DM + bj * 128); gbv[m][bj] = *(const u32x2*)(GB + ro0 + (size_t)(ai * 128 + m * 16) * DM + bj * 128); }
                asm volatile("" ::: "memory");
#pragma unroll
                for (int m = 0; m < 4; ++m)
#pragma unroll
                    for (int bj = 0; bj < 2; ++bj) { const u32x2 ga = gav[m][bj], gb = gbv[m][bj];
#pragma unroll
                        for (int e = 0; e < 4; ++e) { acc[ai][bj][m][0][e] *= ub2f(ga.x, e) * __builtin_amdgcn_rcpf(ub2f(gb.x, e)); acc[ai][bj][m][1][e] *= ub2f(ga.y, e) * __builtin_amdgcn_rcpf(ub2f(gb.y, e)); } }
            }
            return true;
        }
#pragma unroll
        for (int ai = 0; ai < 2; ++ai) {
            u32x2 gbv[4][2];
#pragma unroll
            for (int m = 0; m < 4; ++m)
#pragma unroll
                for (int bj = 0; bj < 2; ++bj) gbv[m][bj] = *(const u32x2*)(GB + ro0 + (size_t)(ai * 128 + m * 16) * DM + bj * 128);
            asm volatile("" ::: "memory");
#pragma unroll
            for (int m = 0; m < 4; ++m)
#pragma unroll
                for (int bj = 0; bj < 2; ++bj) { const u32x2 gb = gbv[m][bj]; f32x4 t0, t1;
#pragma unroll
                    for (int e = 0; e < 4; ++e) { t0[e] = acc[ai][bj][m][0][e] * (ub2f(gb.x, e) * (1.f / 255.f)); t1[e] = acc[ai][bj][m][1][e] * (ub2f(gb.y, e) * (1.f / 255.f)); }
                    u32x4 w; w.x = cvt_pk_bf16(t0[0], t0[1]); w.y = cvt_pk_bf16(t0[2], t0[3]); w.z = cvt_pk_bf16(t1[0], t1[1]); w.w = cvt_pk_bf16(t1[2], t1[3]);
                    *(u32x4*)(MG + ro0 + (size_t)(ai * 128 + m * 16) * DM + bj * 128) = w; }
            asm volatile("" ::: "memory");
        }
        return false;
    }
};
struct SchedUp {
    const char* Y; const char* WUT; int G, c; unsigned pa, pb;
    __device__ __forceinline__ bool next(int i, Tile& u) const {
        const int L = (i >> 1) * G + c; if (L >= 512) return false;
        int pm, pn; static_order(L, 32, 16, pm, pn); const int seg = i & 1;
        u.pm = pm; u.pn = pn; u.kind = seg; u.nt = seg ? WB / BK : WAO / BK;
        u.A = Y + (size_t)pm * 256 * (YW * 2) + (seg ? WAO * 2 : 0); u.B = WUT + (size_t)pn * 256 * (YW * 2) + (seg ? WAO * 2 : 0);
        return true;
    }
};
struct EpiOut {
    const float *x, *g2; float* H; bf16_t* XN2; float* SSQ;
    __device__ __forceinline__ bool operator()(f32x4 (&acc)[2][2][4][2], const Tile& u, int wr, int wc, int fr, int fq, PG8_LAS unsigned char*) const {
        const int col0 = u.pn * 256 + 32 * wc + 8 * fq;
        f32x4 gg[2][2];
#pragma unroll
        for (int bj = 0; bj < 2; ++bj) { gg[bj][0] = *(const f32x4*)(g2 + col0 + bj * 128); gg[bj][1] = *(const f32x4*)(g2 + col0 + bj * 128 + 4); }
#pragma unroll
        for (int ai = 0; ai < 2; ++ai)
#pragma unroll
        for (int mh = 0; mh < 2; ++mh) {
            f32x4 xv[2][2][2];
#pragma unroll
            for (int m2 = 0; m2 < 2; ++m2)
#pragma unroll
                for (int bj = 0; bj < 2; ++bj) { const size_t ro = (size_t)(u.pm * 256 + ai * 128 + wr * 64 + (mh * 2 + m2) * 16 + fr) * DM + col0 + bj * 128; xv[m2][bj][0] = *(const f32x4*)(x + ro); xv[m2][bj][1] = *(const f32x4*)(x + ro + 4); }
            asm volatile("" ::: "memory");
#pragma unroll
            for (int m2 = 0; m2 < 2; ++m2) { const int m = mh * 2 + m2; const int row = u.pm * 256 + ai * 128 + wr * 64 + m * 16 + fr; const size_t ro = (size_t)row * DM + col0; float ss = 0.f;
#pragma unroll
                for (int bj = 0; bj < 2; ++bj) { const f32x4 h0 = xv[m2][bj][0] + acc[ai][bj][m][0], h1 = xv[m2][bj][1] + acc[ai][bj][m][1];
                    *(f32x4*)(H + ro + bj * 128) = h0; *(f32x4*)(H + ro + bj * 128 + 4) = h1;
                    ss += (h0[0] * h0[0] + h0[1] * h0[1]) + (h0[2] * h0[2] + h0[3] * h0[3]) + (h1[0] * h1[0] + h1[1] * h1[1]) + (h1[2] * h1[2] + h1[3] * h1[3]);
                    const f32x4 a = h0 * gg[bj][0], b = h1 * gg[bj][1];
                    u32x4 w; w.x = cvt_pk_bf16(a[0], a[1]); w.y = cvt_pk_bf16(a[2], a[3]); w.z = cvt_pk_bf16(b[0], b[1]); w.w = cvt_pk_bf16(b[2], b[3]);
                    *(u32x4*)(XN2 + ro + bj * 128) = w; }
                ss += __shfl_xor(ss, 16); ss += __shfl_xor(ss, 32);
                if (fq == 0) SSQ[row * 64 + u.pn * 4 + wc] = ss; }
            asm volatile("" ::: "memory");
        }
        return false;
    }
};
struct EpiHiLo {
    bf16_t *H, *L; int ldc, pad;
    __device__ __forceinline__ bool operator()(f32x4 (&acc)[2][2][4][2], const Tile& u, int wr, int wc, int fr, int fq, PG8_LAS unsigned char*) const {
        const int col0 = u.pn * 256 + 32 * wc + 8 * fq;
#pragma unroll
        for (int ai = 0; ai < 2; ++ai)
#pragma unroll
            for (int m = 0; m < 4; ++m) { const size_t ro = (size_t)(u.pm * 256 + ai * 128 + wr * 64 + m * 16 + fr) * ldc + col0;
#pragma unroll
                for (int bj = 0; bj < 2; ++bj) { u32x4 wh, wl;
#pragma unroll
                    for (int e = 0; e < 4; ++e) { const float a = acc[ai][bj][m][e >> 1][2 * (e & 1)], b = acc[ai][bj][m][e >> 1][2 * (e & 1) + 1];
                        const unsigned hp = cvt_pk_bf16(a, b); wh[e] = hp; wl[e] = cvt_pk_bf16(a - __uint_as_float(hp << 16), b - __uint_as_float(hp & 0xffff0000u)); }
                    *(u32x4*)(H + ro + bj * 128) = wh; *(u32x4*)(L + ro + bj * 128) = wl; } }
        return false;
    }
};
struct EpiNull { int kp, pad; __device__ __forceinline__ bool operator()(f32x4 (&acc)[2][2][4][2], const Tile& u, int, int, int, int, PG8_LAS unsigned char*) const {
        float s = 0.f;
#pragma unroll
        for (int a = 0; a < 2; ++a)
#pragma unroll
            for (int b = 0; b < 2; ++b)
#pragma unroll
                for (int m = 0; m < 4; ++m)
#pragma unroll
                    for (int n = 0; n < 2; ++n) s += acc[a][b][m][n][0] + acc[a][b][m][n][1] + acc[a][b][m][n][2] + acc[a][b][m][n][3];
        if (s == 1.2345e33f) *(float*)u.A = s;
        return kp && u.kind == 0; } };
struct SchedPlain {
    const char* A; const char* B; int G, c, nM, nN, K; unsigned pa, pb;
    __device__ __forceinline__ bool next(int i, Tile& u) const {
        const int L = i * G + c; if (L >= nM * nN) return false;
        int pm, pn; static_order(L, nM, nN, pm, pn);
        u.pm = pm; u.pn = pn; u.kind = 0; u.nt = K / BK; u.A = A + (size_t)pm * 256 * pa; u.B = B + (size_t)pn * 256 * pb;
        return true;
    }
};
}
namespace tk {
typedef short bf16x8 __attribute__((ext_vector_type(8)));
typedef float f32x16 __attribute__((ext_vector_type(16)));
typedef float f32x4 __attribute__((ext_vector_type(4)));
typedef unsigned u32x4 __attribute__((ext_vector_type(4)));
__device__ __forceinline__ unsigned f2key(float f) { const unsigned b = __float_as_uint(f); return b ^ ((unsigned)((int)b >> 31) | 0x80000000u); }
__device__ __forceinline__ float key2f(unsigned u) { return __uint_as_float(u ^ (~(unsigned)((int)u >> 31) | 0x80000000u)); }
__device__ __forceinline__ unsigned umax(unsigned a, unsigned b) { return a > b ? a : b; }
__device__ __forceinline__ unsigned umin(unsigned a, unsigned b) { return a < b ? a : b; }
#define TK_CE(x, y) do { const unsigned lo_ = umin(x, y), hi_ = umax(x, y); x = hi_; y = lo_; } while (0)
__device__ __forceinline__ void sort16_desc(unsigned (&a)[16]) {
    TK_CE(a[0], a[1]);
    TK_CE(a[3], a[2]);
    TK_CE(a[4], a[5]);
    TK_CE(a[7], a[6]);
    TK_CE(a[8], a[9]);
    TK_CE(a[11], a[10]);
    TK_CE(a[12], a[13]);
    TK_CE(a[15], a[14]);
    TK_CE(a[0], a[2]);
    TK_CE(a[1], a[3]);
    TK_CE(a[6], a[4]);
    TK_CE(a[7], a[5]);
    TK_CE(a[8], a[10]);
    TK_CE(a[9], a[11]);
    TK_CE(a[14], a[12]);
    TK_CE(a[15], a[13]);
    TK_CE(a[0], a[1]);
    TK_CE(a[2], a[3]);
    TK_CE(a[5], a[4]);
    TK_CE(a[7], a[6]);
    TK_CE(a[8], a[9]);
    TK_CE(a[10], a[11]);
    TK_CE(a[13], a[12]);
    TK_CE(a[15], a[14]);
    TK_CE(a[0], a[4]);
    TK_CE(a[1], a[5]);
    TK_CE(a[2], a[6]);
    TK_CE(a[3], a[7]);
    TK_CE(a[12], a[8]);
    TK_CE(a[13], a[9]);
    TK_CE(a[14], a[10]);
    TK_CE(a[15], a[11]);
    TK_CE(a[0], a[2]);
    TK_CE(a[1], a[3]);
    TK_CE(a[4], a[6]);
    TK_CE(a[5], a[7]);
    TK_CE(a[10], a[8]);
    TK_CE(a[11], a[9]);
    TK_CE(a[14], a[12]);
    TK_CE(a[15], a[13]);
    TK_CE(a[0], a[1]);
    TK_CE(a[2], a[3]);
    TK_CE(a[4], a[5]);
    TK_CE(a[6], a[7]);
    TK_CE(a[9], a[8]);
    TK_CE(a[11], a[10]);
    TK_CE(a[13], a[12]);
    TK_CE(a[15], a[14]);
    TK_CE(a[0], a[8]);
    TK_CE(a[1], a[9]);
    TK_CE(a[2], a[10]);
    TK_CE(a[3], a[11]);
    TK_CE(a[4], a[12]);
    TK_CE(a[5], a[13]);
    TK_CE(a[6], a[14]);
    TK_CE(a[7], a[15]);
    TK_CE(a[0], a[4]);
    TK_CE(a[1], a[5]);
    TK_CE(a[2], a[6]);
    TK_CE(a[3], a[7]);
    TK_CE(a[8], a[12]);
    TK_CE(a[9], a[13]);
    TK_CE(a[10], a[14]);
    TK_CE(a[11], a[15]);
    TK_CE(a[0], a[2]);
    TK_CE(a[1], a[3]);
    TK_CE(a[4], a[6]);
    TK_CE(a[5], a[7]);
    TK_CE(a[8], a[10]);
    TK_CE(a[9], a[11]);
    TK_CE(a[12], a[14]);
    TK_CE(a[13], a[15]);
    TK_CE(a[0], a[1]);
    TK_CE(a[2], a[3]);
    TK_CE(a[4], a[5]);
    TK_CE(a[6], a[7]);
    TK_CE(a[8], a[9]);
    TK_CE(a[10], a[11]);
    TK_CE(a[12], a[13]);
    TK_CE(a[14], a[15]);
}
__device__ __forceinline__ void merge_top16(unsigned (&a)[16], const unsigned (&b)[16]) {
    a[0] = umax(a[0], b[15]);
    a[1] = umax(a[1], b[14]);
    a[2] = umax(a[2], b[13]);
    a[3] = umax(a[3], b[12]);
    a[4] = umax(a[4], b[11]);
    a[5] = umax(a[5], b[10]);
    a[6] = umax(a[6], b[9]);
    a[7] = umax(a[7], b[8]);
    a[8] = umax(a[8], b[7]);
    a[9] = umax(a[9], b[6]);
    a[10] = umax(a[10], b[5]);
    a[11] = umax(a[11], b[4]);
    a[12] = umax(a[12], b[3]);
    a[13] = umax(a[13], b[2]);
    a[14] = umax(a[14], b[1]);
    a[15] = umax(a[15], b[0]);
    TK_CE(a[0], a[8]);
    TK_CE(a[1], a[9]);
    TK_CE(a[2], a[10]);
    TK_CE(a[3], a[11]);
    TK_CE(a[4], a[12]);
    TK_CE(a[5], a[13]);
    TK_CE(a[6], a[14]);
    TK_CE(a[7], a[15]);
    TK_CE(a[0], a[4]);
    TK_CE(a[1], a[5]);
    TK_CE(a[2], a[6]);
    TK_CE(a[3], a[7]);
    TK_CE(a[8], a[12]);
    TK_CE(a[9], a[13]);
    TK_CE(a[10], a[14]);
    TK_CE(a[11], a[15]);
    TK_CE(a[0], a[2]);
    TK_CE(a[1], a[3]);
    TK_CE(a[4], a[6]);
    TK_CE(a[5], a[7]);
    TK_CE(a[8], a[10]);
    TK_CE(a[9], a[11]);
    TK_CE(a[12], a[14]);
    TK_CE(a[13], a[15]);
    TK_CE(a[0], a[1]);
    TK_CE(a[2], a[3]);
    TK_CE(a[4], a[5]);
    TK_CE(a[6], a[7]);
    TK_CE(a[8], a[9]);
    TK_CE(a[10], a[11]);
    TK_CE(a[12], a[13]);
    TK_CE(a[14], a[15]);
}
#define TK_CE2(i, l) do { const bool sw_ = k[i] < k[l]; const unsigned k0_ = sw_ ? k[l] : k[i], k1_ = sw_ ? k[i] : k[l], p0_ = sw_ ? p[l] : p[i], p1_ = sw_ ? p[i] : p[l]; k[i] = k0_; k[l] = k1_; p[i] = p0_; p[l] = p1_; } while (0)
__device__ __forceinline__ void sort16_desc2(unsigned (&k)[16], unsigned (&p)[16]) {
    TK_CE2(0, 1);
    TK_CE2(3, 2);
    TK_CE2(4, 5);
    TK_CE2(7, 6);
    TK_CE2(8, 9);
    TK_CE2(11, 10);
    TK_CE2(12, 13);
    TK_CE2(15, 14);
    TK_CE2(0, 2);
    TK_CE2(1, 3);
    TK_CE2(6, 4);
    TK_CE2(7, 5);
    TK_CE2(8, 10);
    TK_CE2(9, 11);
    TK_CE2(14, 12);
    TK_CE2(15, 13);
    TK_CE2(0, 1);
    TK_CE2(2, 3);
    TK_CE2(5, 4);
    TK_CE2(7, 6);
    TK_CE2(8, 9);
    TK_CE2(10, 11);
    TK_CE2(13, 12);
    TK_CE2(15, 14);
    TK_CE2(0, 4);
    TK_CE2(1, 5);
    TK_CE2(2, 6);
    TK_CE2(3, 7);
    TK_CE2(12, 8);
    TK_CE2(13, 9);
    TK_CE2(14, 10);
    TK_CE2(15, 11);
    TK_CE2(0, 2);
    TK_CE2(1, 3);
    TK_CE2(4, 6);
    TK_CE2(5, 7);
    TK_CE2(10, 8);
    TK_CE2(11, 9);
    TK_CE2(14, 12);
    TK_CE2(15, 13);
    TK_CE2(0, 1);
    TK_CE2(2, 3);
    TK_CE2(4, 5);
    TK_CE2(6, 7);
    TK_CE2(9, 8);
    TK_CE2(11, 10);
    TK_CE2(13, 12);
    TK_CE2(15, 14);
    TK_CE2(0, 8);
    TK_CE2(1, 9);
    TK_CE2(2, 10);
    TK_CE2(3, 11);
    TK_CE2(4, 12);
    TK_CE2(5, 13);
    TK_CE2(6, 14);
    TK_CE2(7, 15);
    TK_CE2(0, 4);
    TK_CE2(1, 5);
    TK_CE2(2, 6);
    TK_CE2(3, 7);
    TK_CE2(8, 12);
    TK_CE2(9, 13);
    TK_CE2(10, 14);
    TK_CE2(11, 15);
    TK_CE2(0, 2);
    TK_CE2(1, 3);
    TK_CE2(4, 6);
    TK_CE2(5, 7);
    TK_CE2(8, 10);
    TK_CE2(9, 11);
    TK_CE2(12, 14);
    TK_CE2(13, 15);
    TK_CE2(0, 1);
    TK_CE2(2, 3);
    TK_CE2(4, 5);
    TK_CE2(6, 7);
    TK_CE2(8, 9);
    TK_CE2(10, 11);
    TK_CE2(12, 13);
    TK_CE2(14, 15);
}
__device__ __forceinline__ void merge_top16_2(unsigned (&k)[16], unsigned (&p)[16], const unsigned (&kb)[16], const unsigned (&pb)[16]) {
    { const bool t_ = kb[15] > k[0]; k[0] = t_ ? kb[15] : k[0]; p[0] = t_ ? pb[15] : p[0]; }
    { const bool t_ = kb[14] > k[1]; k[1] = t_ ? kb[14] : k[1]; p[1] = t_ ? pb[14] : p[1]; }
    { const bool t_ = kb[13] > k[2]; k[2] = t_ ? kb[13] : k[2]; p[2] = t_ ? pb[13] : p[2]; }
    { const bool t_ = kb[12] > k[3]; k[3] = t_ ? kb[12] : k[3]; p[3] = t_ ? pb[12] : p[3]; }
    { const bool t_ = kb[11] > k[4]; k[4] = t_ ? kb[11] : k[4]; p[4] = t_ ? pb[11] : p[4]; }
    { const bool t_ = kb[10] > k[5]; k[5] = t_ ? kb[10] : k[5]; p[5] = t_ ? pb[10] : p[5]; }
    { const bool t_ = kb[9] > k[6]; k[6] = t_ ? kb[9] : k[6]; p[6] = t_ ? pb[9] : p[6]; }
    { const bool t_ = kb[8] > k[7]; k[7] = t_ ? kb[8] : k[7]; p[7] = t_ ? pb[8] : p[7]; }
    { const bool t_ = kb[7] > k[8]; k[8] = t_ ? kb[7] : k[8]; p[8] = t_ ? pb[7] : p[8]; }
    { const bool t_ = kb[6] > k[9]; k[9] = t_ ? kb[6] : k[9]; p[9] = t_ ? pb[6] : p[9]; }
    { const bool t_ = kb[5] > k[10]; k[10] = t_ ? kb[5] : k[10]; p[10] = t_ ? pb[5] : p[10]; }
    { const bool t_ = kb[4] > k[11]; k[11] = t_ ? kb[4] : k[11]; p[11] = t_ ? pb[4] : p[11]; }
    { const bool t_ = kb[3] > k[12]; k[12] = t_ ? kb[3] : k[12]; p[12] = t_ ? pb[3] : p[12]; }
    { const bool t_ = kb[2] > k[13]; k[13] = t_ ? kb[2] : k[13]; p[13] = t_ ? pb[2] : p[13]; }
    { const bool t_ = kb[1] > k[14]; k[14] = t_ ? kb[1] : k[14]; p[14] = t_ ? pb[1] : p[14]; }
    { const bool t_ = kb[0] > k[15]; k[15] = t_ ? kb[0] : k[15]; p[15] = t_ ? pb[0] : p[15]; }
    TK_CE2(0, 8);
    TK_CE2(1, 9);
    TK_CE2(2, 10);
    TK_CE2(3, 11);
    TK_CE2(4, 12);
    TK_CE2(5, 13);
    TK_CE2(6, 14);
    TK_CE2(7, 15);
    TK_CE2(0, 4);
    TK_CE2(1, 5);
    TK_CE2(2, 6);
    TK_CE2(3, 7);
    TK_CE2(8, 12);
    TK_CE2(9, 13);
    TK_CE2(10, 14);
    TK_CE2(11, 15);
    TK_CE2(0, 2);
    TK_CE2(1, 3);
    TK_CE2(4, 6);
    TK_CE2(5, 7);
    TK_CE2(8, 10);
    TK_CE2(9, 11);
    TK_CE2(12, 14);
    TK_CE2(13, 15);
    TK_CE2(0, 1);
    TK_CE2(2, 3);
    TK_CE2(4, 5);
    TK_CE2(6, 7);
    TK_CE2(8, 9);
    TK_CE2(10, 11);
    TK_CE2(12, 13);
    TK_CE2(14, 15);
}
#define TK_CAND(slot, who, a, b) do { const unsigned kx_ = f2key(f1[a] + f2[b]), px_ = ((t0[a] & 127u) << 7) | (t1[b] & 127u); \
    if (who == 0) { ck[slot] = hh ? ck[slot] : kx_; cp[slot] = hh ? cp[slot] : px_; } else { ck[slot] = hh ? kx_ : ck[slot]; cp[slot] = hh ? px_ : cp[slot]; } } while (0)
__device__ __forceinline__ void make_cands(const unsigned (&t0)[16], const unsigned (&t1)[16], const float (&f1)[16], const float (&f2)[16], int hh, unsigned (&ck)[32], unsigned (&cp)[32]) {
    TK_CAND(0, 0, 0, 0);
    TK_CAND(0, 1, 0, 1);
    TK_CAND(1, 0, 0, 2);
    TK_CAND(1, 1, 0, 3);
    TK_CAND(2, 0, 0, 4);
    TK_CAND(2, 1, 0, 5);
    TK_CAND(3, 0, 0, 6);
    TK_CAND(3, 1, 0, 7);
    TK_CAND(4, 0, 0, 8);
    TK_CAND(4, 1, 0, 9);
    TK_CAND(5, 0, 0, 10);
    TK_CAND(5, 1, 0, 11);
    TK_CAND(6, 0, 0, 12);
    TK_CAND(6, 1, 0, 13);
    TK_CAND(7, 0, 0, 14);
    TK_CAND(7, 1, 0, 15);
    TK_CAND(8, 0, 1, 0);
    TK_CAND(8, 1, 1, 1);
    TK_CAND(9, 0, 1, 2);
    TK_CAND(9, 1, 1, 3);
    TK_CAND(10, 0, 1, 4);
    TK_CAND(10, 1, 1, 5);
    TK_CAND(11, 0, 1, 6);
    TK_CAND(11, 1, 1, 7);
    TK_CAND(12, 0, 2, 0);
    TK_CAND(12, 1, 2, 1);
    TK_CAND(13, 0, 2, 2);
    TK_CAND(13, 1, 2, 3);
    TK_CAND(14, 0, 2, 4);
    TK_CAND(14, 1, 3, 0);
    TK_CAND(15, 0, 3, 1);
    TK_CAND(15, 1, 3, 2);
    TK_CAND(16, 0, 3, 3);
    TK_CAND(16, 1, 4, 0);
    TK_CAND(17, 0, 4, 1);
    TK_CAND(17, 1, 4, 2);
    TK_CAND(18, 0, 5, 0);
    TK_CAND(18, 1, 5, 1);
    TK_CAND(19, 0, 6, 0);
    TK_CAND(19, 1, 6, 1);
    TK_CAND(20, 0, 7, 0);
    TK_CAND(20, 1, 7, 1);
    TK_CAND(21, 0, 8, 0);
    TK_CAND(21, 1, 9, 0);
    TK_CAND(22, 0, 10, 0);
    TK_CAND(22, 1, 11, 0);
    TK_CAND(23, 0, 12, 0);
    TK_CAND(23, 1, 13, 0);
    TK_CAND(24, 0, 14, 0);
    TK_CAND(24, 1, 15, 0);
}
__device__ __forceinline__ void score_group(const char* kh, const char* kl, unsigned kvo, const bf16x8 (&qh)[8], const bf16x8 (&ql)[8], int ng, int hh, unsigned (&key)[16]) {
    f32x16 sacc;
#pragma unroll
    for (int r = 0; r < 16; ++r) sacc[r] = 0.f;
#pragma unroll
    for (int ks = 0; ks < 8; ++ks) { const bf16x8 ah = *(const bf16x8*)(kh + 32 * ks + kvo), al = *(const bf16x8*)(kl + 32 * ks + kvo);
        sacc = __builtin_amdgcn_mfma_f32_32x32x16_bf16(ah, qh[ks], sacc, 0, 0, 0); sacc = __builtin_amdgcn_mfma_f32_32x32x16_bf16(ah, ql[ks], sacc, 0, 0, 0); sacc = __builtin_amdgcn_mfma_f32_32x32x16_bf16(al, qh[ks], sacc, 0, 0, 0); }
#pragma unroll
    for (int r = 0; r < 16; ++r) key[r] = (f2key(sacc[r]) & ~127u) | (unsigned)(32 * ng + (r & 3) + 8 * (r >> 2) + 4 * hh);
    sort16_desc(key);

}
__device__ __forceinline__ void select_half(const bf16_t* __restrict__ QH, const bf16_t* __restrict__ QL, const bf16_t* __restrict__ SKH, const bf16_t* __restrict__ SKL, int t0, int h, int c, int tok, int hh, unsigned (&out)[16]) {
    bf16x8 qh[8], ql[8];
    { const char* qr = (const char*)(QH + (size_t)t0 * PQW + h * PQD + c * PQH); const char* qs = (const char*)(QL + (size_t)t0 * PQW + h * PQD + c * PQH); const unsigned qvo = (unsigned)(tok * PQW + 8 * hh) * 2u;
#pragma unroll
      for (int ks = 0; ks < 8; ++ks) { qh[ks] = *(const bf16x8*)(qr + 32 * ks + qvo); ql[ks] = *(const bf16x8*)(qs + 32 * ks + qvo); } }
    const char* kh = (const char*)(SKH + (size_t)(h * 2 + c) * NKEYS * PQH); const char* kl = (const char*)(SKL + (size_t)(h * 2 + c) * NKEYS * PQH); const unsigned kvo = (unsigned)(tok * PQH + 8 * hh) * 2u;
    unsigned k1[16], k2[16], k3[16];
    score_group(kh, kl, kvo, qh, ql, 0, hh, out);
    score_group(kh + 32 * PQH * 2, kl + 32 * PQH * 2, kvo, qh, ql, 1, hh, k1);
    merge_top16(out, k1);
    score_group(kh + 64 * PQH * 2, kl + 64 * PQH * 2, kvo, qh, ql, 2, hh, k2);
    score_group(kh + 96 * PQH * 2, kl + 96 * PQH * 2, kvo, qh, ql, 3, hh, k3);
    merge_top16(k2, k3); merge_top16(out, k2);
#pragma unroll
    for (int i = 0; i < 16; ++i) k1[i] = (unsigned)__shfl_xor((int)out[i], 32);
    merge_top16(out, k1);
}
__device__ __forceinline__ void topk_item(const bf16_t* __restrict__ QH, const bf16_t* __restrict__ QL, const bf16_t* __restrict__ SKH, const bf16_t* __restrict__ SKL, const float* __restrict__ ssq,
                                          int* __restrict__ EIDX, float* __restrict__ GATE, int h, int t0, int tok, int hh) {
        const int t = t0 + tok;
        unsigned top0[16], top1[16];
        select_half(QH, QL, SKH, SKL, t0, h, 0, tok, hh, top0);
        asm volatile("" ::: "memory");
        select_half(QH, QL, SKH, SKL, t0, h, 1, tok, hh, top1);
        float f1[16], f2[16];
#pragma unroll
        for (int i = 0; i < 16; ++i) { f1[i] = key2f(top0[i]); f2[i] = key2f(top1[i]); }
        unsigned ck32[32], cp32[32];
#pragma unroll
        for (int i = 0; i < 32; ++i) { ck32[i] = 0u; cp32[i] = 0u; }
        make_cands(top0, top1, f1, f2, hh, ck32, cp32);
        unsigned ck[2][16], cp[2][16];
#pragma unroll
        for (int i = 0; i < 16; ++i) { ck[0][i] = ck32[i]; cp[0][i] = cp32[i]; ck[1][i] = ck32[16 + i]; cp[1][i] = cp32[16 + i]; }
        sort16_desc2(ck[0], cp[0]); sort16_desc2(ck[1], cp[1]); merge_top16_2(ck[0], cp[0], ck[1], cp[1]);
        unsigned pk[16], pp[16];
#pragma unroll
        for (int i = 0; i < 16; ++i) { pk[i] = (unsigned)__shfl_xor((int)ck[0][i], 32); pp[i] = (unsigned)__shfl_xor((int)cp[0][i], 32); }
        merge_top16_2(ck[0], cp[0], pk, pp);
        float ss = 0.f; { const f32x4* sp = (const f32x4*)(ssq + (size_t)t * 64);
#pragma unroll
            for (int i = 0; i < 16; ++i) { const f32x4 v = sp[i]; ss += (v[0] + v[1]) + (v[2] + v[3]); } }
        const float rstd = rsqrtf(ss * (1.f / DM) + EPS);
        float ez[16]; float den = 0.f; const float z0 = key2f(ck[0][0]);
#pragma unroll
        for (int i = 0; i < 16; ++i) { ez[i] = __expf((key2f(ck[0][i]) - z0) * rstd); den += ez[i]; }
        const float inv = 1.f / den;
        int* ep = EIDX + (size_t)t * PK + h * TOPK; float* gp = GATE + (size_t)t * PK + h * TOPK;
        if (hh == 0) {
            *(u32x4*)(ep) = (u32x4){cp[0][0], cp[0][1], cp[0][2], cp[0][3]}; *(u32x4*)(ep + 4) = (u32x4){cp[0][4], cp[0][5], cp[0][6], cp[0][7]};
            *(f32x4*)(gp) = (f32x4){ez[0] * inv, ez[1] * inv, ez[2] * inv, ez[3] * inv}; *(f32x4*)(gp + 4) = (f32x4){ez[4] * inv, ez[5] * inv, ez[6] * inv, ez[7] * inv};
        } else {
            *(u32x4*)(ep + 8) = (u32x4){cp[0][8], cp[0][9], cp[0][10], cp[0][11]}; *(u32x4*)(ep + 12) = (u32x4){cp[0][12], cp[0][13], cp[0][14], cp[0][15]};
            *(f32x4*)(gp + 8) = (f32x4){ez[8] * inv, ez[9] * inv, ez[10] * inv, ez[11] * inv}; *(f32x4*)(gp + 12) = (f32x4){ez[12] * inv, ez[13] * inv, ez[14] * inv, ez[15] * inv};
        }
}
__device__ __forceinline__ void phase_topk2(const bf16_t* __restrict__ QH, const bf16_t* __restrict__ QL, const bf16_t* __restrict__ SKH, const bf16_t* __restrict__ SKL, const float* __restrict__ ssq,
                                            int* __restrict__ EIDX, float* __restrict__ GATE, int vcu, int G) {
    const int lane = threadIdx.x & 63, tok = lane & 31, hh = lane >> 5, gw = vcu * 8 + __builtin_amdgcn_readfirstlane(threadIdx.x >> 6), NGW = G * 8;
    for (int it = gw; it < PH * (S / 32); it += NGW) {
        int h = it & 7; asm volatile("" : "+s"(h));
        topk_item(QH, QL, SKH, SKL, ssq, EIDX, GATE, h, (it >> 3) * 32, tok, hh);
    }
}
template <class Sched>
__device__ __forceinline__ void phase_topk2_tiles(const bf16_t* __restrict__ QH, const bf16_t* __restrict__ QL, const bf16_t* __restrict__ SKH, const bf16_t* __restrict__ SKL, const float* __restrict__ ssq,
                                                  int* __restrict__ EIDX, float* __restrict__ GATE, const Sched& Sc) {
    const int lane = threadIdx.x & 63, tok = lane & 31, hh = lane >> 5, w = __builtin_amdgcn_readfirstlane(threadIdx.x >> 6);
    pg8::Tile u;
    for (int i = 0; Sc.next(i, u); ++i) { int h = u.pn; asm volatile("" : "+s"(h)); topk_item(QH, QL, SKH, SKL, ssq, EIDX, GATE, h, u.pm * 256 + 32 * w, tok, hh); }
}
}
namespace p0 {
template <int CTRL> __device__ __forceinline__ float dppf(float v) { return __builtin_bit_cast(float, __builtin_amdgcn_update_dpp(0, __builtin_bit_cast(int, v), CTRL, 0xf, 0xf, true)); }
__device__ __forceinline__ float rl(float v, int l) { return __builtin_bit_cast(float, __builtin_amdgcn_readlane(__builtin_bit_cast(int, v), l)); }
__device__ __forceinline__ float wsum_u(float v) { v += dppf<0xB1>(v); v += dppf<0x4E>(v); v += dppf<0x141>(v); v += dppf<0x140>(v); return (rl(v, 0) + rl(v, 16)) + (rl(v, 32) + rl(v, 48)); }
__device__ __forceinline__ float wmax_u(float v) { v = fmaxf(v, dppf<0xB1>(v)); v = fmaxf(v, dppf<0x4E>(v)); v = fmaxf(v, dppf<0x141>(v)); v = fmaxf(v, dppf<0x140>(v)); return fmaxf(fmaxf(rl(v, 0), rl(v, 16)), fmaxf(rl(v, 32), rl(v, 48))); }
__device__ __forceinline__ unsigned pk2(float lo, float hi) { return (unsigned)f2bf(lo) | ((unsigned)f2bf(hi) << 16); }
struct TrDesc { const float* src; bf16_t* dst; int ldw, pitch, split; };
__device__ __forceinline__ void tr_load(const TrDesc& d, int lane, float (&r)[32]) {
    const int l = lane & 31, adj = l >= d.split ? NHB : 0; const float* s = d.src + (size_t)(lane >> 5) * d.ldw + l + adj;
#pragma unroll
    for (int i = 0; i < 32; ++i) r[i] = s[(size_t)(2 * i) * d.ldw];
}
__device__ __forceinline__ void tr_store(const TrDesc& d, int lane, const float (&r)[32], LAS float* scr) {
#pragma unroll
    for (int i = 0; i < 32; ++i) scr[(2 * i + (lane >> 5)) * 33 + (lane & 31)] = r[i];
    asm volatile("s_waitcnt lgkmcnt(0)" ::: "memory");
    const int c = lane & 7;
#pragma unroll
    for (int j = 0; j < 4; ++j) { const int n = (lane >> 3) + 8 * j; const LAS float* s = scr + (8 * c) * 33 + n;
        uint4 o; o.x = pk2(s[0 * 33], s[1 * 33]); o.y = pk2(s[2 * 33], s[3 * 33]); o.z = pk2(s[4 * 33], s[5 * 33]); o.w = pk2(s[6 * 33], s[7 * 33]);
        *(uint4*)(d.dst + (size_t)n * d.pitch + 8 * c) = o; }
    asm volatile("s_waitcnt lgkmcnt(0)" ::: "memory");
}
struct Args { const float *x, *g1, *w_in, *bfg, *wua, *wub, *wout, *wq, *pu, *pv, *sk; bf16_t *WUT, *WOT, *WQT, *UB, *VB; float* LOGF; bf16_t *SKH, *SKL; unsigned char *XN8, *W8; float *XS, *WS8; float* WFC; unsigned* WFM; };
constexpr int I_1 = 0  , I_UA = 12 * 128, I_UB = 28 * 128, I_O = 64 * 128, I_Q = 64 * 64, NITEMS = I_1 + I_UA + I_UB + I_O + I_Q;
__device__ __forceinline__ TrDesc decode(const Args& a, int it);
__device__ __forceinline__ void transpose_range(const Args& a, LAS float* scr, int lane, int it0, int step, int it_end) {
    float ra[32], rb[32]; int it = it0; TrDesc d0{}, d1{};
    if (it < it_end) { d0 = decode(a, it); tr_load(d0, lane, ra); }
    while (it < it_end) { const int itn = it + step; const bool more = itn < it_end;
        if (more) { d1 = decode(a, itn); tr_load(d1, lane, rb); }
        tr_store(d0, lane, ra, scr);
        if (more) { d0 = d1;
#pragma unroll
            for (int i = 0; i < 32; ++i) ra[i] = rb[i]; }
        it = itn; }
}
__device__ __forceinline__ void prep(const Args& a, LAS unsigned char* lds, int bx, int G, int c_lo, int c_hi) {
    const int tid = threadIdx.x, lane = tid & 63, wave = __builtin_amdgcn_readfirstlane(tid >> 6), gw = bx * 8 + wave, NGW = G * 8;
    LAS float* scr = (LAS float*)(lds + wave * 8448);
    const int nrow = (2 * NEXP + NGW - 1) / NGW, nit = (NITEMS - I_1 + NGW - 1) / NGW;
    for (int c = c_lo; c < c_hi; ++c) {
        { const int j0 = (nrow * c) / 8, j1 = (nrow * (c + 1)) / 8; float4 va[16];
          for (int j = j0; j < j1; ++j) { const int row = gw + NGW * j; if (row < 2 * NEXP) { pr::tq_load(a.pu, a.pv, row, lane, va); pr::tq_pack((unsigned char*)a.UB, (float*)a.VB, row, lane, va); } } }
        { const int j0 = (nit * c) / 8, j1 = (nit * (c + 1)) / 8; if (j1 > j0) transpose_range(a, scr, lane, I_1 + gw + NGW * j0, NGW, (I_1 + gw + NGW * j1) < NITEMS ? (I_1 + gw + NGW * j1) : NITEMS); }
        if (c == 0) for (int i = bx * 512 + tid; i < PH * 2 * NKEYS * PQH; i += G * 512) { const float v = a.sk[i]; const bf16_t hb = f2bf(v); a.SKH[i] = hb; a.SKL[i] = f2bf(v - bf2f(hb)); }
    }
}
__device__ __forceinline__ void gate_w8(const Args& a, LAS unsigned char* lds, int bx, int G) {
    const int tid = threadIdx.x, lane = tid & 63, wave = __builtin_amdgcn_readfirstlane(tid >> 6), c = tid & 15, g = tid >> 4;
    constexpr int P = DM + 16;
    LAS unsigned char* T = lds; LAS float* cm = (LAS float*)(lds + 16 * P);
    const int half = (bx >> 3) & 1, bi = ((bx >> 4) << 3) | (bx & 7), nbase = G >> 1; const bool paired = (G & 15) == 0;
    auto blk = [&](int pj) -> int { return paired ? 2 * (bi + nbase * pj) + half : bx + G * pj; };
    auto srcof = [&](int cb) -> const float* { const int n0 = 16 * cb, n1 = n0 - 2 * (WA + WB);
        const int sc = n0 < 2 * WA ? n0 : (n1 < 0 ? C_QB + n0 - 2 * WA : (n1 < WA ? C_VA + n1 : (n1 < WA + WB ? C_VB + n1 - WA : C_GA + n1 - WA - WB)));
        return a.w_in + (size_t)(4 * g) * INC + sc + c; };
    constexpr int NB = (INC - NHB) / 16;
    float v[32][4];
    if (blk(0) < NB) { const float* src = srcof(blk(0));
#pragma unroll
        for (int i = 0; i < 32; ++i)
#pragma unroll
            for (int j = 0; j < 4; ++j) v[i][j] = src[(size_t)(128 * i + j) * INC]; }
    for (int pj = 0;; ++pj) { const int cb = blk(pj); if (cb >= NB) break; const int n0 = 16 * cb;
        float mx = 0.f;
#pragma unroll
        for (int i = 0; i < 32; ++i)
#pragma unroll
            for (int j = 0; j < 4; ++j) mx = fmaxf(mx, fabsf(v[i][j]));
        mx = fmaxf(mx, __shfl_xor(mx, 16)); mx = fmaxf(mx, __shfl_xor(mx, 32));
        if (lane < 16) cm[wave * 16 + lane] = mx;
        __syncthreads();
        float m = cm[c];
#pragma unroll
        for (int w = 1; w < 8; ++w) m = fmaxf(m, cm[w * 16 + c]);
        const float iv = m > 0.f ? 127.f / m : 0.f;
        if (tid < 16) a.WS8[n0 + tid] = m * (1.f / 127.f);
#pragma unroll
        for (int i = 0; i < 32; ++i) { unsigned pk = 0;
#pragma unroll
            for (int j = 0; j < 4; ++j) pk |= ((unsigned)__float2int_rn(v[i][j] * iv) & 0xffu) << (8 * j);
            *(LAS unsigned*)(T + c * P + 128 * i + 4 * g) = pk; }
        __syncthreads();
        { const int cbn = blk(pj + 1); if (cbn < NB) { const float* src = srcof(cbn);
#pragma unroll
            for (int i = 0; i < 32; ++i)
#pragma unroll
                for (int j = 0; j < 4; ++j) v[i][j] = src[(size_t)(128 * i + j) * INC]; } }
        asm volatile("" ::: "memory");
#pragma unroll
        for (int j = 0; j < 8; ++j) { const int q = tid + 512 * j, cc = q >> 8, off = (q & 255) * 16;
            *(pg8::u32x4*)(a.W8 + (size_t)(n0 + cc) * DM + off) = *(const LAS pg8::u32x4*)(T + cc * P + off); }
        __syncthreads();
    }
}
__device__ __forceinline__ void run(const Args& a, LAS unsigned char* lds, int vcu, int G) {
    const int tid = threadIdx.x, lane = tid & 63, wave = __builtin_amdgcn_readfirstlane(tid >> 6);
    const int gw = vcu * 8 + wave, NGW = G * 8;
    LAS float* scr = (LAS float*)(lds + wave * 8448);
    gate_w8(a, lds, blockIdx.x, G);
    __syncthreads();
    for (int k = blockIdx.x * 512 + tid; k < DM; k += G * 512) { const float2* src = (const float2*)(a.w_in + (size_t)k * INC + C_F);
#pragma unroll
        for (int j = 0; j < 7; ++j) { const float2 v = src[j]; a.WFC[(2 * j) * DM + k] = v.x; a.WFC[(2 * j + 1) * DM + k] = v.y;
            const float m0 = wmax_u(fabsf(v.x)), m1 = wmax_u(fabsf(v.y));
            if (lane == 0) { atomicMax(a.WFM + 2 * j, __float_as_uint(m0)); atomicMax(a.WFM + 2 * j + 1, __float_as_uint(m1)); } } }
    for (int m = gw; m < S; m += NGW) {
        const float4* xr = (const float4*)(a.x + (size_t)m * DM); float v[8][8]; float ss = 0.f;
#pragma unroll
        for (int j = 0; j < 8; ++j) { const float4 p = xr[j * 128 + 2 * lane], q = xr[j * 128 + 2 * lane + 1];
            v[j][0] = p.x; v[j][1] = p.y; v[j][2] = p.z; v[j][3] = p.w; v[j][4] = q.x; v[j][5] = q.y; v[j][6] = q.z; v[j][7] = q.w;
            ss += (p.x * p.x + p.y * p.y) + (p.z * p.z + p.w * p.w) + (q.x * q.x + q.y * q.y) + (q.z * q.z + q.w * q.w); }
        const float rstd = rsqrtf(wsum_u(ss) * (1.f / DM) + EPS);
#pragma unroll
        for (int j = 0; j < 8; ++j) { const float4 p = ((const float4*)a.g1)[j * 128 + 2 * lane], q = ((const float4*)a.g1)[j * 128 + 2 * lane + 1];
            v[j][0] *= rstd * p.x; v[j][1] *= rstd * p.y; v[j][2] *= rstd * p.z; v[j][3] *= rstd * p.w; v[j][4] *= rstd * q.x; v[j][5] *= rstd * q.y; v[j][6] *= rstd * q.z; v[j][7] *= rstd * q.w;
        }
        { float am = 0.f;
#pragma unroll
          for (int j = 0; j < 8; ++j)
#pragma unroll
              for (int e = 0; e < 8; ++e) am = fmaxf(am, fabsf(v[j][e]));
          am = wmax_u(am); const float iv = am > 0.f ? 127.f / am : 0.f;
#pragma unroll
          for (int j = 0; j < 8; ++j) { unsigned lo = 0, hi = 0;
#pragma unroll
              for (int b = 0; b < 4; ++b) { lo |= ((unsigned)__float2int_rn(v[j][b] * iv) & 0xffu) << (8 * b); hi |= ((unsigned)__float2int_rn(v[j][4 + b] * iv) & 0xffu) << (8 * b); }
              *(uint2*)(a.XN8 + (size_t)m * DM + j * 512 + 8 * lane) = make_uint2(lo, hi); }
          if (lane == 0) a.XS[m] = am * (1.f / 127.f); }
    }
}
__device__ __forceinline__ void flogits(const Args& a, LAS unsigned char* lds, int vcu, int G) {
    const int tid = threadIdx.x, lane = tid & 63, wave = __builtin_amdgcn_readfirstlane(tid >> 6), gw = vcu * 8 + wave, NGW = G * 8;
    for (int i = tid; i < NHB * (DM / 4); i += 512) { const int h = i / (DM / 4), k4 = i % (DM / 4); const float m = __uint_as_float(a.WFM[h]); const float iv = m > 0.f ? 127.f / m : 0.f;
        const float4 v = *(const float4*)(a.WFC + (size_t)h * DM + 4 * k4);
        *(LAS unsigned*)(lds + h * DM + 4 * k4) = ((unsigned)__float2int_rn(v.x * iv) & 0xffu) | (((unsigned)__float2int_rn(v.y * iv) & 0xffu) << 8) | (((unsigned)__float2int_rn(v.z * iv) & 0xffu) << 16) | ((unsigned)__float2int_rn(v.w * iv) << 24); }
    __syncthreads();
    const float ws = lane < NHB ? __uint_as_float(a.WFM[lane]) * (1.f / 127.f) : 0.f, bf = lane < NHB ? a.bfg[lane] : 0.f;
    pg8::u32x4 xn_[4];
    if (gw < S) {
#pragma unroll
        for (int j = 0; j < 4; ++j) xn_[j] = *(const pg8::u32x4*)(a.XN8 + (size_t)gw * DM + j * 1024 + lane * 16); }
    for (int m = gw; m < S; m += NGW) {
        pg8::u32x4 xr[4];
#pragma unroll
        for (int j = 0; j < 4; ++j) xr[j] = xn_[j];
        if (m + NGW < S) {
#pragma unroll
            for (int j = 0; j < 4; ++j) xn_[j] = *(const pg8::u32x4*)(a.XN8 + (size_t)(m + NGW) * DM + j * 1024 + lane * 16); }
        const float xs = a.XS[m]; int dl = 0;
#pragma unroll 2
        for (int h = 0; h < NHB; ++h) { int d = 0;
#pragma unroll
            for (int j = 0; j < 4; ++j) { const pg8::u32x4 w = *(const LAS pg8::u32x4*)(lds + h * DM + j * 1024 + lane * 16);
#pragma unroll
                for (int q = 0; q < 4; ++q) d = __builtin_amdgcn_sdot4((int)xr[j][q], (int)w[q], d, false); }
            d = pr::wave_sum_i_u(d); dl = (lane == h) ? d : dl; }
        if (lane < NHB) { const float z = (float)dl * xs * ws + bf; a.LOGF[m * 16 + lane] = fminf(z, 0.f) - log1pf(expf(-fabsf(z))); }
    }
    __syncthreads();
}
__device__ __forceinline__ TrDesc decode(const Args& a, int it) { int r = it; TrDesc d;
    if (r < I_UA) { const int kb = r / 128, nb = r % 128; d.src = a.wua + (size_t)(64 * kb) * DM + 32 * nb; d.ldw = DM; d.split = 32; d.dst = a.WUT + (size_t)(32 * nb) * YW + 64 * kb; d.pitch = YW; return d; } r -= I_UA;
    if (r < I_UB) { const int kb = r / 128, nb = r % 128; d.src = a.wub + (size_t)(64 * kb) * DM + 32 * nb; d.ldw = DM; d.split = 32; d.dst = a.WUT + WAO + (size_t)(32 * nb) * YW + 64 * kb; d.pitch = YW; return d; } r -= I_UB;
    if (r < I_O) { const int kb = r / 128, nb = r % 128; d.src = a.wout + (size_t)(64 * kb) * DM + 32 * nb; d.ldw = DM; d.split = 32; d.dst = a.WOT + (size_t)(32 * nb) * DM + 64 * kb; d.pitch = DM; return d; } r -= I_O;
    { const int kb = r / 64, nb = r % 64; d.src = a.wq + (size_t)(64 * kb) * PQW + 32 * nb; d.ldw = PQW; d.split = 32; d.dst = a.WQT + (size_t)(32 * nb) * DM + 64 * kb; d.pitch = DM; return d; } }
}
namespace att {
typedef short bf16x8 __attribute__((ext_vector_type(8)));
typedef short s16x4 __attribute__((ext_vector_type(4)));
typedef float f32x16 __attribute__((ext_vector_type(16)));
typedef float f32x4 __attribute__((ext_vector_type(4)));
typedef unsigned u32x4 __attribute__((ext_vector_type(4)));
typedef unsigned u32x2 __attribute__((ext_vector_type(2)));
constexpr int KOFF = 0, VOFF = 32768, COFF = 65536, LDS_BYTES = 66048;
struct Unit { const char* q; const char* k; const char* v; size_t pitch; int i0; const float* c2; float slope2; char* o; size_t opitch; float* mo; float* lo; int mpitch; float thr; };
#define ATT_MFMA(a, b, c) __builtin_amdgcn_mfma_f32_32x32x16_bf16((a), (b), (c), 0, 0, 0)
__device__ __forceinline__ unsigned pk_bf16(float lo, float hi) { return pg8::cvt_pk_bf16(lo, hi); }

template <bool FOX>
__device__ __forceinline__ void unit(LAS unsigned char* lds, const Unit& u) {
    const int tid = threadIdx.x, w = __builtin_amdgcn_readfirstlane(tid >> 6), lane = tid & 63, c = lane & 31, h = lane >> 5;
    const int imin = u.i0 + 32 * w, imax = imin + 31, irow = imin + c;
    int T_lo = (u.i0 - 128 > 0 ? u.i0 - 128 : 0) >> 6; const int T_hi = (u.i0 + 255) >> 6;
    if (FOX) {
        const int nT = u.i0 >> 6; const float c0 = u.c2[u.i0]; T_lo = nT;
        for (int base = 0; base < nT; base += 64) { const int tl = base + lane; const bool keep = (tl < nT) ? (c0 - u.c2[64 * tl + 63] > -u.thr) : true;
            const unsigned long long bm = __ballot(keep); if (bm) { const int f = base + __ffsll((long long)bm) - 1; T_lo = f < nT ? f : nT; break; } }
        T_lo = __builtin_amdgcn_readfirstlane(T_lo);
    }
    const int w_lo = FOX ? T_lo : ((imin - 128 > 0 ? imin - 128 : 0) >> 6), w_hi = imax >> 6;
    const int dr = lane >> 4, dp = lane & 15;
    unsigned ksrc[2], vsrc[2];
#pragma unroll
    for (int j = 0; j < 2; ++j) { const int row = 8 * w + 4 * j + dr; ksrc[j] = (unsigned)(row * u.pitch) + ((dp ^ (row & 15)) << 4); vsrc[j] = (unsigned)(row * u.pitch) + ((dp ^ ((row & 3) << 2)) << 4); }
    const size_t tstep = 64 * u.pitch;
#define ATT_ISSUE(T, b) do { const char* kb_ = u.k + (size_t)(T) * tstep; const char* vb_ = u.v + (size_t)(T) * tstep; \
        _Pragma("unroll") for (int j_ = 0; j_ < 2; ++j_) { \
            __builtin_amdgcn_global_load_lds((const unsigned*)(kb_ + ksrc[j_]), (LAS unsigned*)(lds + KOFF + (b) * 16384 + (8 * w + 4 * j_) * 256), 16, 0, 0); \
            __builtin_amdgcn_global_load_lds((const unsigned*)(vb_ + vsrc[j_]), (LAS unsigned*)(lds + VOFF + (b) * 16384 + (8 * w + 4 * j_) * 256), 16, 0, 0); } \
        if (FOX && w == 0) __builtin_amdgcn_global_load_lds((const unsigned*)(u.c2 + (T) * 64 + lane), (LAS unsigned*)(lds + COFF + (b) * 256), 4, 0, 0); } while (0)
    int koff[8], voff[4];
#pragma unroll
    for (int ks = 0; ks < 8; ++ks) koff[ks] = c * 256 + (((2 * ks + h) ^ (lane & 15)) << 4);
    { const int q4 = (lane & 15) >> 2, gi = (lane >> 4) & 1, p = lane & 3;
#pragma unroll
      for (int dg = 0; dg < 4; ++dg) voff[dg] = (4 * h + q4) * 256 + ((4 * (dg ^ q4) + 2 * gi + (p >> 1)) << 4) + 8 * (p & 1); }
    bf16x8 qf[8];
    { const char* qrow = u.q + (size_t)irow * u.pitch + h * 16;
#pragma unroll
      for (int ks = 0; ks < 8; ++ks) qf[ks] = *(const bf16x8*)(qrow + ks * 32); }
    const float ci = FOX ? u.c2[irow] : 0.f;
    float m = -1e30f, l = 0.f;
    f32x16 O[4];
#pragma unroll
    for (int dg = 0; dg < 4; ++dg)
#pragma unroll
        for (int r = 0; r < 16; ++r) O[dg][r] = 0.f;
    asm volatile("" ::: "memory"); __builtin_amdgcn_s_barrier(); asm volatile("" ::: "memory");
    ATT_ISSUE(T_lo, 0);
    int b = 0;
    for (int T = T_lo; T <= T_hi; ++T, b ^= 1) {
        asm volatile("s_waitcnt vmcnt(0)" ::: "memory");
        __builtin_amdgcn_s_barrier(); asm volatile("" ::: "memory");
        if (T < T_hi) ATT_ISSUE(T + 1, b ^ 1);
        if (T < w_lo || T > w_hi) continue;
        const LAS unsigned char* kb = lds + KOFF + b * 16384; const LAS unsigned char* vb = lds + VOFF + b * 16384;
        f32x16 S0, S1;
#pragma unroll
        for (int r = 0; r < 16; ++r) { S0[r] = 0.f; S1[r] = 0.f; }
#pragma unroll
        for (int ks = 0; ks < 8; ++ks) { const bf16x8 k0 = *(const LAS bf16x8*)(kb + koff[ks]), k1 = *(const LAS bf16x8*)(kb + 8192 + koff[ks]);
            S0 = ATT_MFMA(k0, qf[ks], S0); S1 = ATT_MFMA(k1, qf[ks], S1); }
        const int j0 = T * 64 + 4 * h;
        if (FOX) { const LAS float* cb = (const LAS float*)(lds + COFF + b * 256) + 4 * h;
#pragma unroll
            for (int g4 = 0; g4 < 4; ++g4) { const f32x4 c0 = *(const LAS f32x4*)(cb + 8 * g4), c1 = *(const LAS f32x4*)(cb + 32 + 8 * g4);
#pragma unroll
                for (int e = 0; e < 4; ++e) { S0[4 * g4 + e] += ci - c0[e]; S1[4 * g4 + e] += ci - c1[e]; } }
        } else { const float d0 = u.slope2 * (float)(j0 - irow);
#pragma unroll
            for (int r = 0; r < 16; ++r) { S0[r] += d0 + u.slope2 * (float)((r & 3) + 8 * (r >> 2)); S1[r] += d0 + u.slope2 * (float)(32 + (r & 3) + 8 * (r >> 2)); } }
        const bool need_mask = (T * 64 + 63 > imin) || (!FOX && T * 64 < imax - 128);
        if (need_mask) { const unsigned lim = FOX ? 0x7fffffffu : 128u; const int dj = irow - j0;
#pragma unroll
            for (int r = 0; r < 16; ++r) { const int kk = (r & 3) + 8 * (r >> 2);
                S0[r] = ((unsigned)(dj - kk) <= lim) ? S0[r] : -INFINITY; S1[r] = ((unsigned)(dj - kk - 32) <= lim) ? S1[r] : -INFINITY; } }
        float mx = fmaxf(S0[0], S1[0]);
#pragma unroll
        for (int r = 1; r < 16; ++r) mx = fmaxf(mx, fmaxf(S0[r], S1[r]));
        mx = fmaxf(mx, __shfl_xor(mx, 32));
        const float mn = fmaxf(m, mx), alpha = __builtin_amdgcn_exp2f(m - mn); m = mn;
        float ps = 0.f;
#pragma unroll
        for (int r = 0; r < 16; ++r) { S0[r] = __builtin_amdgcn_exp2f(S0[r] - mn); S1[r] = __builtin_amdgcn_exp2f(S1[r] - mn); ps += S0[r] + S1[r]; }
        l = l * alpha + ps;
#pragma unroll
        for (int dg = 0; dg < 4; ++dg)
#pragma unroll
            for (int r = 0; r < 16; ++r) O[dg][r] *= alpha;
        bf16x8 pf[4];
#pragma unroll
        for (int s = 0; s < 4; ++s) { u32x4 pk;
#pragma unroll
            for (int e = 0; e < 4; ++e) { const int r = 8 * (s & 1) + 2 * e; pk[e] = (s < 2) ? pk_bf16(S0[r], S0[r + 1]) : pk_bf16(S1[r], S1[r + 1]); }
            pf[s] = __builtin_bit_cast(bf16x8, pk); }
#pragma unroll
        for (int s = 0; s < 4; ++s)
#pragma unroll
            for (int dg = 0; dg < 4; ++dg) {
                const s16x4 lo = __builtin_amdgcn_ds_read_tr16_b64_v4i16((LAS s16x4*)(vb + voff[dg] + s * 4096));
                const s16x4 hi = __builtin_amdgcn_ds_read_tr16_b64_v4i16((LAS s16x4*)(vb + voff[dg] + s * 4096 + 2048));
                const bf16x8 vf = __builtin_shufflevector(lo, hi, 0, 1, 2, 3, 4, 5, 6, 7);
                O[dg] = ATT_MFMA(vf, pf[s], O[dg]); }
    }
    const float lt = l + __shfl_xor(l, 32), inv = 1.f / lt;
    char* orow = u.o + (size_t)irow * u.opitch + h * 8;
#pragma unroll
    for (int dg = 0; dg < 4; ++dg)
#pragma unroll
        for (int g4 = 0; g4 < 4; ++g4) { u32x2 wv; wv.x = pk_bf16(O[dg][4 * g4] * inv, O[dg][4 * g4 + 1] * inv); wv.y = pk_bf16(O[dg][4 * g4 + 2] * inv, O[dg][4 * g4 + 3] * inv);
            *(u32x2*)(orow + dg * 64 + g4 * 16) = wv; }
    if (!FOX && h == 0) { u.mo[(size_t)irow * u.mpitch] = m; u.lo[(size_t)irow * u.mpitch] = lt; }
#undef ATT_ISSUE
}
__device__ __forceinline__ void scan_head(const float* __restrict__ logf, float* __restrict__ c2, int h, LAS float* part) {
    const int tid = threadIdx.x; float v[16]; float s = 0.f;
#pragma unroll
    for (int i = 0; i < 16; ++i) { s += logf[(tid * 16 + i) * 16 + h]; v[i] = s; }
    part[tid] = s; __syncthreads();
    for (int o = 1; o < 512; o <<= 1) { const float t = (tid >= o) ? part[tid - o] : 0.f; __syncthreads(); part[tid] += t; __syncthreads(); }
    const float base = tid ? part[tid - 1] : 0.f;
#pragma unroll
    for (int i = 0; i < 16; ++i) c2[(size_t)h * S + tid * 16 + i] = (base + v[i]) * LOG2E;
    __syncthreads();
}
__device__ __forceinline__ void phase_a(LAS unsigned char* lds, const bf16_t* QA, const bf16_t* KA, const bf16_t* VA, bf16_t* OA, float* MA, float* LA, int vcu, int G) {
    for (int it = vcu; it < NHA * 32; it += G) {
        const int hd = it >> 5, uu = it & 31, g = hd / 6, r = group_dil(g), nper = 32 / r, cc = uu / nper, n = uu % nper;
        Unit u; const size_t off = ((size_t)cc * WA + hd * HD) * 2;
        u.q = (const char*)QA + off; u.k = (const char*)KA + off; u.v = (const char*)VA + off; u.pitch = (size_t)r * WA * 2; u.i0 = n * 256; u.c2 = nullptr;
        u.slope2 = exp2f(-8.f * (float)(hd + 1) / 18.f) * (float)r * LOG2E; u.o = (char*)OA + off; u.opitch = u.pitch; u.mo = MA + cc * NHA + hd; u.lo = LA + cc * NHA + hd; u.mpitch = r * NHA; u.thr = 0.f;
        unit<false>(lds, u);
    }
}
__device__ __forceinline__ void phase_b(LAS unsigned char* lds, const bf16_t* QB, const bf16_t* KB, const bf16_t* VB, const float* C2, bf16_t* Y, const float* gq, const float* gk, int vcu, int G) {
    float thr; { const int lane = threadIdx.x & 63; const float a = wave_max(fmaxf(fabsf(gq[lane]), fabsf(gq[lane + 64]))), b = wave_max(fmaxf(fabsf(gk[lane]), fabsf(gk[lane + 64]))); thr = 38.f + 2.f * (128.f * QSCALE * a * b); }
    for (int pass = 0; pass * G < NHB * 32; ++pass) {
        const int idx = (pass & 1) ? (pass + 1) * G - 1 - vcu : pass * G + vcu; if (idx >= NHB * 32) continue;
        const int blk = 31 - idx / NHB, hd = idx % NHB;
        Unit u; u.q = (const char*)QB + hd * HD * 2; u.k = (const char*)KB + hd * HD * 2; u.v = (const char*)VB + hd * HD * 2; u.pitch = (size_t)WB * 2; u.i0 = blk * 256; u.c2 = C2 + (size_t)hd * S;
        u.slope2 = 0.f; u.o = (char*)Y + (WAO + hd * HD) * 2; u.opitch = (size_t)YW * 2; u.mo = nullptr; u.lo = nullptr; u.mpitch = 0; u.thr = thr;
        unit<true>(lds, u);
    }
}
__device__ __forceinline__ void phase_merge(const bf16_t* __restrict__ OA, const float* __restrict__ MA, const float* __restrict__ LA, bf16_t* __restrict__ Y, int vcu, int G) {
    const int lane = threadIdx.x & 63, gw = vcu * 8 + __builtin_amdgcn_readfirstlane(threadIdx.x >> 6), NGW = G * 8, sub = lane >> 4, dl = lane & 15;
#pragma unroll 2
    for (int it = gw; it < S * 6 / 4; it += NGW) { const int pr = it * 4 + sub, t = pr / 6, j = pr % 6;
        float mg[3], lg[3]; u32x4 ov[3];
#pragma unroll
        for (int g = 0; g < 3; ++g) { mg[g] = MA[t * NHA + g * 6 + j]; lg[g] = LA[t * NHA + g * 6 + j]; ov[g] = *(const u32x4*)(OA + (size_t)t * WA + (g * 6 + j) * HD + 8 * dl); }
        const float ms = fmaxf(mg[0], fmaxf(mg[1], mg[2]));
        float num[8], den = 0.f;
#pragma unroll
        for (int e = 0; e < 8; ++e) num[e] = 0.f;
#pragma unroll
        for (int g = 0; g < 3; ++g) { const float wl = exp2f(mg[g] - ms) * lg[g]; den += wl;
#pragma unroll
            for (int e = 0; e < 4; ++e) { num[2 * e] += wl * __uint_as_float(ov[g][e] << 16); num[2 * e + 1] += wl * __uint_as_float(ov[g][e] & 0xffff0000u); } }
        const float inv = 1.f / den; u32x4 o;
#pragma unroll
        for (int e = 0; e < 4; ++e) o[e] = pk_bf16(num[2 * e] * inv, num[2 * e + 1] * inv);
        *(u32x4*)(Y + (size_t)t * YW + j * HD + 8 * dl) = o; }
}
}
constexpr int MEGA_LDS = 147456;
constexpr int LDS_CTL_OFF = 131072 + 8192;
struct MArgs { const float* in[16]; float* out; unsigned char* ws; int ph_lo, ph_hi; };
__global__ void __launch_bounds__(512, 2) mega(MArgs a) {
    extern __shared__ __attribute__((aligned(16))) unsigned char lds_raw[];
    LAS unsigned char* lds = (LAS unsigned char*)lds_raw;
    const int tid = threadIdx.x, G = gridDim.x, bx = blockIdx.x;
    const int vcu = (G % 8 == 0) ? (bx % 8) * (G / 8) + bx / 8 : bx;
    unsigned char* ws = a.ws;
    volatile LAS unsigned* ctlw = (volatile LAS unsigned*)(lds + LDS_CTL_OFF);
    if (tid < 16) ctlw[tid] = 0u;
    __syncthreads();
    XcdBarrier bar = xcd_barrier_post((unsigned*)(ws + WS_CTL) + 4096, ctlw);
    const int lo = a.ph_lo, hi = a.ph_hi;
#define IN(k) (lo <= (k) && (k) < hi)
#define BOTH(k) (IN(k) && IN((k) + 1))
    p0::Args pa{a.in[0], a.in[1], a.in[2], a.in[3], a.in[8], a.in[9], a.in[10], a.in[12], a.in[14], a.in[15], a.in[13],
                (bf16_t*)(ws + WS_WUT), (bf16_t*)(ws + WS_WOT), (bf16_t*)(ws + WS_WQT), (bf16_t*)(ws + WS_UB), (bf16_t*)(ws + WS_VB), (float*)(ws + WS_LOGF), (bf16_t*)(ws + WS_WFT), (bf16_t*)(ws + WS_WFT) + PH * 2 * NKEYS * PQH,
                (unsigned char*)(ws + WS_XN8), (unsigned char*)(ws + WS_W8), (float*)(ws + WS_XS), (float*)(ws + WS_WS8), (float*)(ws + WS_LOGF + 512 * 1024), (unsigned*)(ws + WS_CTL) + 128};
    if (IN(0)) {
        p0::run(pa, lds, vcu, G);
        if (BOTH(0)) xcd_barrier(bar);
    }
    if (IN(1)) {
        pg8::Sched1 S1{(const char*)(ws + WS_XN8), (const char*)(ws + WS_W8), G, bx, 32, DM / 128, DM, DM};
        pg8::Epi1 E1{ws, (const float*)(ws + WS_XS), (const float*)(ws + WS_WS8), a.in[4], a.in[5], a.in[6], a.in[7]};
        p0::flogits(pa, lds, vcu, G);
        p0::prep(pa, lds, bx, G, 0, bx & 7);
        __syncthreads();
        pg8::gemm_phase<pg8::Epi1, pg8::Sched1, true>(lds, S1, E1);
        { pg8::Sched1 S8{(const char*)(ws + WS_XN8), (const char*)(ws + WS_W8) + (size_t)8192 * DM, G, bx, 48, DM / 128, DM, DM};
          pg8::EpiGate8 E8{ws, (const float*)(ws + WS_XS), (const float*)(ws + WS_WS8) + 8192};
          pg8::gemm_phase<pg8::EpiGate8, pg8::Sched1, true>(lds, S8, E8); }
        p0::prep(pa, lds, bx, G, bx & 7, 8);
        if (BOTH(1)) xcd_barrier(bar);
    }
    if (IN(2)) {
        if (bx < NHB) att::scan_head((const float*)(ws + WS_LOGF), (float*)(ws + WS_C2), bx, (LAS float*)lds);
        att::phase_a(lds, (const bf16_t*)(ws + WS_QA), (const bf16_t*)(ws + WS_KA), (const bf16_t*)(ws + WS_VAN), (bf16_t*)(ws + WS_OA), (float*)(ws + WS_MA), (float*)(ws + WS_LA), vcu, G);
        if (BOTH(2)) xcd_barrier(bar);
    }
    if (IN(3)) {
        att::phase_b(lds, (const bf16_t*)(ws + WS_QB), (const bf16_t*)(ws + WS_KB), (const bf16_t*)(ws + WS_VBN), (const float*)(ws + WS_C2), (bf16_t*)(ws + WS_Y), a.in[6], a.in[7], vcu, G);
        att::phase_merge((const bf16_t*)(ws + WS_OA), (const float*)(ws + WS_MA), (const float*)(ws + WS_LA), (bf16_t*)(ws + WS_Y), vcu, G);
        if (BOTH(3)) xcd_barrier(bar);
    }
    if (IN(4)) {
        pg8::SchedUp SU{(const char*)(ws + WS_Y), (const char*)(ws + WS_WUT), G, bx, YW * 2, YW * 2};
        pg8::EpiUp EU{(const unsigned char*)(ws + WS_GA), (const unsigned char*)(ws + WS_GB), (bf16_t*)(ws + WS_MERGED)};
        pg8::gemm_phase<pg8::EpiUp, pg8::SchedUp>(lds, SU, EU);
        if (BOTH(4)) xcd_barrier(bar);
    }
    if (IN(5)) {
        pg8::SchedPlain SO{(const char*)(ws + WS_MERGED), (const char*)(ws + WS_WOT), G, bx, 32, 16, DM, DM * 2, DM * 2};
        pg8::EpiOut EO{a.in[0], a.in[11], a.out, (bf16_t*)(ws + WS_XN), (float*)(ws + WS_SSQ)};
        pg8::gemm_phase<pg8::EpiOut, pg8::SchedPlain>(lds, SO, EO);
        if (BOTH(5)) xcd_barrier(bar);
    }
    if (IN(6)) {
        pg8::SchedPlain SQ{(const char*)(ws + WS_XN), (const char*)(ws + WS_WQT), G, bx, 32, 8, DM, DM * 2, DM * 2};
        pg8::EpiHiLo EQ{(bf16_t*)(ws + WS_QP), (bf16_t*)(ws + WS_QP) + (size_t)S * PQW, PQW, 0};
        pg8::gemm_phase<pg8::EpiHiLo, pg8::SchedPlain>(lds, SQ, EQ);
        tk::phase_topk2_tiles((const bf16_t*)(ws + WS_QP), (const bf16_t*)(ws + WS_QP) + (size_t)S * PQW, (const bf16_t*)(ws + WS_WFT), (const bf16_t*)(ws + WS_WFT) + PH * 2 * NKEYS * PQH, (const float*)(ws + WS_SSQ), (int*)(ws + WS_EIDX), (float*)(ws + WS_GATE), SQ);
        pr::quant_tokens((const bf16_t*)(ws + WS_XN), (unsigned char*)(ws + WS_MERGED), (float*)(ws + WS_MA), vcu * 8 + __builtin_amdgcn_readfirstlane(tid >> 6), G * 8, tid & 63);
        if (BOTH(6)) xcd_barrier(bar);
    }
    if (IN(8)) {
        if ((G & 7) == 0) {
            pr::phase_udot((const unsigned char*)(ws + WS_MERGED), (const int*)(ws + WS_EIDX), (const unsigned char*)(ws + WS_UB), (int*)(ws + WS_OA), bx, G);
            xcd_barrier(bar);
            pr::phase_vsum2((const int*)(ws + WS_OA), (const float*)(ws + WS_MA), (const float*)(ws + WS_SSQ), (const int*)(ws + WS_EIDX), (const float*)(ws + WS_GATE), (const unsigned char*)(ws + WS_UB) + (size_t)NEXP * DM,
                           (const float*)(ws + WS_VB), (const float*)(ws + WS_VB) + NEXP, a.out, vcu, G);
        } else {
            pr::phase_gather8((const bf16_t*)(ws + WS_XN), (const float*)(ws + WS_SSQ), (const int*)(ws + WS_EIDX), (const float*)(ws + WS_GATE), (const unsigned char*)(ws + WS_UB), (const unsigned char*)(ws + WS_UB) + (size_t)NEXP * DM,
                              (const float*)(ws + WS_VB), (const float*)(ws + WS_VB) + NEXP, a.out, vcu, G);
        }
    }
#undef IN
#undef BOTH
}
static int mega_grid() {
    static int grid = 0;
    if (!grid) { int dev = 0, cus = 0, per_cu = 0; hipGetDevice(&dev); hipDeviceGetAttribute(&cus, hipDeviceAttributeMultiprocessorCount, dev);
        hipFuncSetAttribute((const void*)mega, hipFuncAttributeMaxDynamicSharedMemorySize, MEGA_LDS);
        hipOccupancyMaxActiveBlocksPerMultiprocessor(&per_cu, (const void*)mega, 512, MEGA_LDS);
        if (per_cu < 1) fprintf(stderr, "mega: occupancy query says %d blocks per CU\n", per_cu);
        grid = cus; }
    return grid;
}
static void launch_mega(void* const* d_in, float* out, unsigned char* ws, hipStream_t st, int lo, int hi) {
    MArgs a{}; for (int i = 0; i < 16; ++i) a.in[i] = (const float*)d_in[i]; a.out = out; a.ws = ws; a.ph_lo = lo; a.ph_hi = hi;
    hipLaunchKernelGGL(mega, dim3(mega_grid()), dim3(512), MEGA_LDS, st, a);
}
extern "C" void kernel_launch(void* const* d_in, const int* in_sizes, int n_in, void* d_out, int out_size, void* d_ws, size_t ws_size, hipStream_t stream) {
    if (n_in != 16 || out_size != S * DM || ws_size < WS_END) { fprintf(stderr, "kernel_launch: unexpected sizes n_in %d out %d ws %zu\n", n_in, out_size, ws_size); return; }
    unsigned char* ws = (unsigned char*)d_ws;
    hipMemsetAsync(ws + WS_CTL, 0, 1 * MiB, stream);
    launch_mega(d_in, (float*)d_out, ws, stream, 0, 9);
}
```

```cpp
#include <hip/hip_runtime.h>
#include <cstdio>
#include <cstdint>

constexpr int S = 8192, DM = 4096, HD = 128;
constexpr int NHA = 18, NHB = 14, WA = NHA * HD  , WB = NHB * HD  , WAO = 6 * HD  ;
constexpr int INC = 3 * WA + 3 * WB + NHB + 2 * DM;
constexpr int C_QA = 0, C_KA = WA, C_VA = 2 * WA, C_QB = 3 * WA, C_KB = 3 * WA + WB, C_VB = 3 * WA + 2 * WB, C_F = 3 * WA + 3 * WB, C_GA = C_F + NHB, C_GB = C_GA + DM;
constexpr int YW = WAO + WB;
constexpr int PH = 8, NKEYS = 128, TOPK = 16, PQD = 256, PQH = 128, PQW = PH * PQD  , NEXP = NKEYS * NKEYS, PK = PH * TOPK  ;
constexpr float EPS = 1e-6f;
constexpr float LOG2E = 1.4426950408889634f;
constexpr float QSCALE = 0.08838834764831845f * LOG2E;

constexpr size_t MiB = 1ull << 20;
constexpr size_t WS_CTL = 0, WS_LOGF = 1 * MiB, WS_C2 = 2 * MiB, WS_MA = 3 * MiB, WS_LA = 4 * MiB, WS_SSQ = 5 * MiB, WS_EIDX = 8 * MiB, WS_GATE = 12 * MiB;
constexpr size_t WS_XN = 16 * MiB, WS_QA = 80 * MiB, WS_KA = 116 * MiB, WS_VAN = 152 * MiB, WS_QB = 188 * MiB, WS_KB = 216 * MiB, WS_VBN = 244 * MiB, WS_GA = 272 * MiB, WS_GB = 336 * MiB;
constexpr size_t WS_OA = 400 * MiB, WS_Y = 436 * MiB, WS_MERGED = 476 * MiB, WS_QP = 540 * MiB, WS_UB = 604 * MiB, WS_VB = 732 * MiB;
constexpr size_t WS_WFT = 1020 * MiB, WS_WUT = 1021 * MiB  , WS_WOT = 1041 * MiB, WS_WQT = 1073 * MiB, WS_XN8 = 1089 * MiB  , WS_XS = 1121 * MiB, WS_W8 = 860 * MiB  , WS_WS8 = 1170 * MiB, WS_END = 1171 * MiB;

#define LAS __attribute__((address_space(3)))
typedef unsigned short bf16_t;
__device__ __forceinline__ float bf2f(bf16_t b) { return __uint_as_float(((unsigned)b) << 16); }
__device__ __forceinline__ bf16_t f2bf(float f) { unsigned u = __float_as_uint(f); u += 0x7fffu + ((u >> 16) & 1u); return (bf16_t)(u >> 16); }
__device__ __forceinline__ float wave_sum(float v) {
#pragma unroll
    for (int o = 1; o < 64; o <<= 1) v += __shfl_xor(v, o);
    return v;
}
__device__ __forceinline__ float wave_max(float v) {
#pragma unroll
    for (int o = 1; o < 64; o <<= 1) v = fmaxf(v, __shfl_xor(v, o));
    return v;
}
__device__ __forceinline__ int wave_min_i(int v) {
#pragma unroll
    for (int o = 1; o < 64; o <<= 1) { int t = __shfl_xor(v, o); v = t < v ? t : v; }
    return v;
}
__device__ __forceinline__ int dil_pos(int t, int r) { return (t % r) * (S / r) + t / r; }
__device__ __forceinline__ int group_dil(int g) { return g == 0 ? 1 : (g == 1 ? 4 : 16); }
#define XB_TMO      128
#define XB_XCNT(j)  (256  + 64 * (j))
#define XB_XSUB(j)  (1280 + 64 * (j))
#define XB_XGEN(j)  (2304 + 64 * (j))
#define XB_TOP      3328
#define XB_TOPGEN   3392
#define XCD_BAR_WORDS 3456
#define XB_SPIN_CAP (1u << 18)
#ifndef LAS
#define LAS __attribute__((address_space(3)))
#endif
__device__ __forceinline__ unsigned xb_ld(unsigned* p)              { return __hip_atomic_load(p, __ATOMIC_RELAXED, __HIP_MEMORY_SCOPE_AGENT); }
__device__ __forceinline__ unsigned xb_add(unsigned* p, unsigned v) { return __hip_atomic_fetch_add(p, v, __ATOMIC_RELAXED, __HIP_MEMORY_SCOPE_AGENT); }
__device__ __forceinline__ unsigned xb_xcc_id() { return (unsigned)__builtin_amdgcn_s_getreg((3 << 11) | 20) & 0xFu; }
#define XB_SPIN(cond, bar) do { unsigned _sp = 0; while (cond) { __builtin_amdgcn_s_sleep(1); \
    if ((++_sp & 255u) == 0u) { if (xb_ld(&(bar)[XB_TMO])) break; if (_sp > XB_SPIN_CAP) { atomicAdd(&(bar)[XB_TMO], 1u); break; } } } } while (0)
struct XcdBarrier { unsigned* bar; unsigned x; volatile LAS unsigned* st; };
__device__ __forceinline__ XcdBarrier xcd_barrier_post(unsigned* bar, volatile LAS unsigned* st) {
    XcdBarrier b; b.bar = bar; b.x = xb_xcc_id(); b.st = st;
    if (threadIdx.x == 0) (void)xb_add(&bar[XB_XCNT(b.x)], 1u);
    return b;
}
__device__ __forceinline__ void xcd_barrier_complete(unsigned* bar, unsigned x, unsigned& nloc, unsigned& nx) {
    const unsigned G = gridDim.x * gridDim.y * gridDim.z;
    unsigned sum, cnt, mine, sp = 0u;
    for (;;) {
        sum = 0u; cnt = 0u; mine = 0u;
#pragma unroll
        for (unsigned j = 0; j < 16; ++j) { const unsigned c = xb_ld(&bar[XB_XCNT(j)]); sum += c; cnt += (c > 0u) ? 1u : 0u; mine = (j == x) ? c : mine; }
        if (sum == G) break;
        __builtin_amdgcn_s_sleep(1);
        if ((++sp & 255u) == 0u) { if (xb_ld(&bar[XB_TMO])) break; if (sp > XB_SPIN_CAP) { atomicAdd(&bar[XB_TMO], 1u); break; } }
    }
    nloc = mine > 0u ? mine : 1u; nx = cnt > 0u ? cnt : 1u;
}
__device__ __forceinline__ void xcd_barrier(const XcdBarrier& b) {
    asm volatile("s_waitcnt vmcnt(0)" ::: "memory");
    __syncthreads();
    if (threadIdx.x == 0) {
        unsigned* bar = b.bar;
        __builtin_amdgcn_s_waitcnt(0);
        unsigned nloc = b.st[0], nx = b.st[1];
        if (nloc == 0u) { xcd_barrier_complete(bar, b.x, nloc, nx); b.st[0] = nloc; b.st[1] = nx; }
        const unsigned old = xb_add(&bar[XB_XSUB(b.x)], 1u);
        const unsigned gen = old / nloc;
        if (old + 1u == (gen + 1u) * nloc) {
            __builtin_amdgcn_fence(__ATOMIC_RELEASE, "agent");
            asm volatile("s_waitcnt vmcnt(0)" ::: "memory");
            const unsigned og = xb_add(&bar[XB_TOP], 1u);
            const unsigned tg = og / nx;
            if (og + 1u == (tg + 1u) * nx) xb_add(&bar[XB_TOPGEN], 1u);
            else XB_SPIN(xb_ld(&bar[XB_TOPGEN]) == tg, bar);
            __builtin_amdgcn_fence(__ATOMIC_ACQUIRE, "agent");
            xb_add(&bar[XB_XGEN(b.x)], 1u);
            asm volatile("s_waitcnt vmcnt(0)" ::: "memory");
        } else {
            XB_SPIN(xb_ld(&bar[XB_XGEN(b.x)]) == gen, bar);
            __builtin_amdgcn_fence(__ATOMIC_ACQUIRE, "agent");
            asm volatile("s_waitcnt vmcnt(0)" ::: "memory");
        }
    }
    __syncthreads();
}
namespace pr {
template <int CTRL> __device__ __forceinline__ float dpp_movf(float v) { return __builtin_bit_cast(float, __builtin_amdgcn_update_dpp(0, __builtin_bit_cast(int, v), CTRL, 0xf, 0xf, true)); }
__device__ __forceinline__ float wave_max_u(float v) {
    v = fmaxf(v, dpp_movf<0xB1>(v)); v = fmaxf(v, dpp_movf<0x4E>(v)); v = fmaxf(v, dpp_movf<0x141>(v)); v = fmaxf(v, dpp_movf<0x140>(v));
    const float a = __builtin_bit_cast(float, __builtin_amdgcn_readlane(__builtin_bit_cast(int, v), 0)), b = __builtin_bit_cast(float, __builtin_amdgcn_readlane(__builtin_bit_cast(int, v), 16)),
                c = __builtin_bit_cast(float, __builtin_amdgcn_readlane(__builtin_bit_cast(int, v), 32)), d = __builtin_bit_cast(float, __builtin_amdgcn_readlane(__builtin_bit_cast(int, v), 48));
    return fmaxf(fmaxf(a, b), fmaxf(c, d));
}
__device__ __forceinline__ float rstd_of(const float* __restrict__ ssq, int t, int lane) { return rsqrtf(wave_sum(ssq[t * 64 + lane]) * (1.f / DM) + EPS); }
__device__ __forceinline__ float gelu_erf(float a) { return 0.5f * a * (1.f + erff(a * 0.70710678118654752f)); }
typedef unsigned u32x4g __attribute__((ext_vector_type(4)));
__device__ __forceinline__ float sb2f(unsigned w, int b) { return (float)(signed char)((w >> (8 * b)) & 0xffu); }
__device__ __forceinline__ void gather_token8(int t, int lane, const bf16_t* __restrict__ XN2, const float* __restrict__ ssq, const int* __restrict__ EIDX, const float* __restrict__ GATE,
                                              const unsigned char* __restrict__ U8, const unsigned char* __restrict__ V8, const float* __restrict__ US, const float* __restrict__ VS, float* __restrict__ out) {
    const float rstd = rstd_of(ssq, t, lane);
    unsigned hq[4][4]; float hs;
    { float hv[4][16]; float am = 0.f;
#pragma unroll
      for (int i = 0; i < 4; ++i) { const u32x4g a = *(const u32x4g*)(XN2 + (size_t)t * DM + i * 1024 + lane * 16), b = *(const u32x4g*)(XN2 + (size_t)t * DM + i * 1024 + lane * 16 + 8);
#pragma unroll
          for (int e = 0; e < 4; ++e) { hv[i][2 * e] = __uint_as_float(a[e] << 16); hv[i][2 * e + 1] = __uint_as_float(a[e] & 0xffff0000u); hv[i][8 + 2 * e] = __uint_as_float(b[e] << 16); hv[i][8 + 2 * e + 1] = __uint_as_float(b[e] & 0xffff0000u); }
#pragma unroll
          for (int e = 0; e < 16; ++e) am = fmaxf(am, fabsf(hv[i][e])); }
      am = wave_max_u(am); hs = am * (1.f / 127.f); const float inv = am > 0.f ? 127.f / am : 0.f;
#pragma unroll
      for (int i = 0; i < 4; ++i)
#pragma unroll
          for (int w = 0; w < 4; ++w) { unsigned pk = 0;
#pragma unroll
              for (int b = 0; b < 4; ++b) pk |= ((unsigned)__float2int_rn(hv[i][4 * w + b] * inv) & 0xffu) << (8 * b);
              hq[i][w] = pk; } }
    const int e0 = EIDX[(size_t)t * PK + lane], e1 = EIDX[(size_t)t * PK + 64 + lane];
    const float g0 = GATE[(size_t)t * PK + lane], g1 = GATE[(size_t)t * PK + 64 + lane];
    const float su0 = US[e0], su1 = US[e1], sv0 = VS[e0], sv1 = VS[e1];
    int d0 = 0, d1 = 0;
#pragma unroll 2
    for (int k = 0; k < PK; ++k) {
        const int e = __builtin_amdgcn_readlane(k < 64 ? e0 : e1, k & 63);
        const unsigned char* row = U8 + (size_t)e * DM + lane * 16; int d = 0;
#pragma unroll
        for (int i = 0; i < 4; ++i) { const u32x4g u = *(const u32x4g*)(row + i * 1024);
#pragma unroll
            for (int w = 0; w < 4; ++w) d = __builtin_amdgcn_sdot4((int)u[w], (int)hq[i][w], d, false); }
#pragma unroll
        for (int o = 1; o < 64; o <<= 1) d += __shfl_xor(d, o);
        if (k < 64) d0 = (lane == k) ? d : d0; else d1 = (lane == (k & 63)) ? d : d1;
    }
    const float act0 = gelu_erf((float)d0 * su0 * hs * rstd) * g0 * sv0, act1 = gelu_erf((float)d1 * su1 * hs * rstd) * g1 * sv1;
    float acc[4][16];
#pragma unroll
    for (int i = 0; i < 4; ++i)
#pragma unroll
        for (int j = 0; j < 16; ++j) acc[i][j] = 0.f;
#pragma unroll 2
    for (int k = 0; k < PK; ++k) {
        const int e = __builtin_amdgcn_readlane(k < 64 ? e0 : e1, k & 63);
        const float a = __builtin_bit_cast(float, __builtin_amdgcn_readlane(__builtin_bit_cast(int, k < 64 ? act0 : act1), k & 63));
        const unsigned char* row = V8 + (size_t)e * DM + lane * 16;
#pragma unroll
        for (int i = 0; i < 4; ++i) { const u32x4g u = *(const u32x4g*)(row + i * 1024);
#pragma unroll
            for (int w = 0; w < 4; ++w)
#pragma unroll
                for (int b = 0; b < 4; ++b) acc[i][4 * w + b] += a * sb2f(u[w], b); }
    }
    float* orow = out + (size_t)t * DM + lane * 16;
#pragma unroll
    for (int i = 0; i < 4; ++i)
#pragma unroll
        for (int w = 0; w < 4; ++w) { float4 o = *(float4*)(orow + i * 1024 + 4 * w); o.x += acc[i][4 * w]; o.y += acc[i][4 * w + 1]; o.z += acc[i][4 * w + 2]; o.w += acc[i][4 * w + 3]; *(float4*)(orow + i * 1024 + 4 * w) = o; }
}
__device__ __forceinline__ void phase_gather8(const bf16_t* __restrict__ XN2, const float* __restrict__ ssq, const int* __restrict__ EIDX, const float* __restrict__ GATE,
                                              const unsigned char* __restrict__ U8, const unsigned char* __restrict__ V8, const float* __restrict__ US, const float* __restrict__ VS, float* __restrict__ out, int vcu, int G) {
    const int lane = threadIdx.x & 63, gw = vcu * 8 + (threadIdx.x >> 6), NGW = G * 8;
    for (int t = gw; t < S; t += NGW) gather_token8(t, lane, XN2, ssq, EIDX, GATE, U8, V8, US, VS, out);
}
__device__ __forceinline__ void tq_load(const float* __restrict__ pu, const float* __restrict__ pv, int row, int lane, float4 (&v)[16]) {
    const float* src = (row < NEXP ? pu + (size_t)row * DM : pv + (size_t)(row - NEXP) * DM) + lane * 16;
#pragma unroll
    for (int i = 0; i < 4; ++i)
#pragma unroll
        for (int w = 0; w < 4; ++w) v[4 * i + w] = *(const float4*)(src + i * 1024 + 4 * w);
}
__device__ __forceinline__ void tq_pack(unsigned char* __restrict__ T8, float* __restrict__ TS, int row, int lane, const float4 (&v)[16]) {
    float am = 0.f;
#pragma unroll
    for (int j = 0; j < 16; ++j) am = fmaxf(am, fmaxf(fmaxf(fabsf(v[j].x), fabsf(v[j].y)), fmaxf(fabsf(v[j].z), fabsf(v[j].w))));
    am = wave_max_u(am); const float inv = am > 0.f ? 127.f / am : 0.f;
#pragma unroll
    for (int i = 0; i < 4; ++i) { u32x4g o;
#pragma unroll
        for (int w = 0; w < 4; ++w) { const float4 x = v[4 * i + w]; o[w] = ((unsigned)__float2int_rn(x.x * inv) & 0xffu) | (((unsigned)__float2int_rn(x.y * inv) & 0xffu) << 8) | (((unsigned)__float2int_rn(x.z * inv) & 0xffu) << 16) | (((unsigned)__float2int_rn(x.w * inv) & 0xffu) << 24); }
        *(u32x4g*)(T8 + (size_t)row * DM + i * 1024 + lane * 16) = o; }
    if (lane == 0) TS[row] = am * (1.f / 127.f);
}
__device__ __forceinline__ void quant_tables(const float* __restrict__ pu, const float* __restrict__ pv, unsigned char* __restrict__ T8, float* __restrict__ TS, int gw, int NGW, int lane) {
    float4 va[16], vb[16]; int row = gw;
    if (row < 2 * NEXP) tq_load(pu, pv, row, lane, va);
    while (row < 2 * NEXP) { const int r1 = row + NGW, r2 = r1 + NGW;
        if (r1 < 2 * NEXP) tq_load(pu, pv, r1, lane, vb);
        tq_pack(T8, TS, row, lane, va);
        if (r1 >= 2 * NEXP) break;
        if (r2 < 2 * NEXP) tq_load(pu, pv, r2, lane, va);
        tq_pack(T8, TS, r1, lane, vb);
        row = r2; }
}
template <int CTRL> __device__ __forceinline__ int dpp_movi(int v) { return __builtin_amdgcn_update_dpp(0, v, CTRL, 0xf, 0xf, true); }
__device__ __forceinline__ int wave_sum_i_u(int v) {
    v += dpp_movi<0xB1>(v); v += dpp_movi<0x4E>(v); v += dpp_movi<0x141>(v); v += dpp_movi<0x140>(v);
    return __builtin_amdgcn_readlane(v, 0) + __builtin_amdgcn_readlane(v, 16) + __builtin_amdgcn_readlane(v, 32) + __builtin_amdgcn_readlane(v, 48);
}
__device__ __forceinline__ void quant_tokens(const bf16_t* __restrict__ XN2, unsigned char* __restrict__ H8, float* __restrict__ HS, int gw, int NGW, int lane) {
    u32x4g na_[4], nb_[4];
    if (gw < S) {
#pragma unroll
        for (int i = 0; i < 4; ++i) { na_[i] = *(const u32x4g*)(XN2 + (size_t)gw * DM + i * 1024 + lane * 16); nb_[i] = *(const u32x4g*)(XN2 + (size_t)gw * DM + i * 1024 + lane * 16 + 8); } }
    for (int t = gw; t < S; t += NGW) {
        float hv[4][16]; float am = 0.f;
#pragma unroll
        for (int i = 0; i < 4; ++i) { const u32x4g a = na_[i], b = nb_[i];
#pragma unroll
            for (int e = 0; e < 4; ++e) { hv[i][2 * e] = __uint_as_float(a[e] << 16); hv[i][2 * e + 1] = __uint_as_float(a[e] & 0xffff0000u); hv[i][8 + 2 * e] = __uint_as_float(b[e] << 16); hv[i][8 + 2 * e + 1] = __uint_as_float(b[e] & 0xffff0000u); }
#pragma unroll
            for (int e = 0; e < 16; ++e) am = fmaxf(am, fabsf(hv[i][e])); }
        if (t + NGW < S) {
#pragma unroll
            for (int i = 0; i < 4; ++i) { na_[i] = *(const u32x4g*)(XN2 + (size_t)(t + NGW) * DM + i * 1024 + lane * 16); nb_[i] = *(const u32x4g*)(XN2 + (size_t)(t + NGW) * DM + i * 1024 + lane * 16 + 8); } }
        am = wave_max_u(am); const float inv = am > 0.f ? 127.f / am : 0.f;
#pragma unroll
        for (int i = 0; i < 4; ++i) { u32x4g o;
#pragma unroll
            for (int w = 0; w < 4; ++w) { unsigned pk = 0;
#pragma unroll
                for (int b = 0; b < 4; ++b) pk |= ((unsigned)__float2int_rn(hv[i][4 * w + b] * inv) & 0xffu) << (8 * b);
                o[w] = pk; }
            *(u32x4g*)(H8 + (size_t)t * DM + i * 1024 + lane * 16) = o; }
        if (lane == 0) HS[t] = am * (1.f / 127.f);
    }
}
__device__ __forceinline__ void phase_udot(const unsigned char* __restrict__ H8, const int* __restrict__ EIDX, const unsigned char* __restrict__ U8, int* __restrict__ D, int bx, int G) {
    const int lane = threadIdx.x & 63, w = __builtin_amdgcn_readfirstlane(threadIdx.x >> 6), p = bx & 7, r = bx >> 3, R = G >> 3;
    for (int tg = r; tg < S / 64; tg += R) {
        const int tb = tg * 64 + 8 * w;
        unsigned hq[8][4][4]; int e0[8], e1[8]; int d0[8], d1[8];
#pragma unroll
        for (int i = 0; i < 8; ++i) {
#pragma unroll
            for (int j = 0; j < 4; ++j) { const u32x4g v = *(const u32x4g*)(H8 + (size_t)(tb + i) * DM + j * 1024 + lane * 16); hq[i][j][0] = v[0]; hq[i][j][1] = v[1]; hq[i][j][2] = v[2]; hq[i][j][3] = v[3]; }
            e0[i] = EIDX[(size_t)(tb + i) * PK + lane]; e1[i] = EIDX[(size_t)(tb + i) * PK + 64 + lane]; }
#pragma unroll
        for (int i = 0; i < 8; ++i) { d0[i] = 0; d1[i] = 0; }
#pragma unroll 1
        for (int s = 0; s < 4; ++s) { const int part = p * 4 + s;
#pragma unroll
            for (int i = 0; i < 8; ++i) {
#pragma unroll
                for (int hf = 0; hf < 2; ++hf) { const int ev = hf ? e1[i] : e0[i];
                    unsigned long long bm = __ballot((ev >> 9) == part);
                    while (bm) {
                        const int k0 = __ffsll((long long)bm) - 1; bm &= bm - 1; const bool two = bm != 0ull; const int k1 = two ? __ffsll((long long)bm) - 1 : k0; bm &= bm - 1;
                        const unsigned char* ra = U8 + (size_t)__builtin_amdgcn_readlane(ev, k0) * DM + lane * 16; const unsigned char* rb = U8 + (size_t)__builtin_amdgcn_readlane(ev, k1) * DM + lane * 16;
                        u32x4g ua[4], ub[4];
#pragma unroll
                        for (int j = 0; j < 4; ++j) { ua[j] = *(const u32x4g*)(ra + j * 1024); ub[j] = *(const u32x4g*)(rb + j * 1024); }
                        int da = 0, db = 0;
#pragma unroll
                        for (int j = 0; j < 4; ++j)
#pragma unroll
                            for (int q = 0; q < 4; ++q) { da = __builtin_amdgcn_sdot4((int)ua[j][q], (int)hq[i][j][q], da, false); db = __builtin_amdgcn_sdot4((int)ub[j][q], (int)hq[i][j][q], db, false); }
                        da = wave_sum_i_u(da); db = wave_sum_i_u(db);
                        if (hf == 0) { d0[i] = lane == k0 ? da : d0[i]; d0[i] = lane == k1 ? db : d0[i]; } else { d1[i] = lane == k0 ? da : d1[i]; d1[i] = lane == k1 ? db : d1[i]; } } } } }
#pragma unroll
        for (int i = 0; i < 8; ++i) {
            if ((e0[i] >> 11) == p) D[(size_t)(tb + i) * PK + lane] = d0[i];
            if ((e1[i] >> 11) == p) D[(size_t)(tb + i) * PK + 64 + lane] = d1[i]; }
    }
}
#define VS_TAKE(E, C, HAS) int E = 0, C = 0; bool HAS = false;     \
        if (bm0_) { const int k_ = __ffsll((long long)bm0_) - 1; bm0_ &= bm0_ - 1; const int w_ = __builtin_amdgcn_readlane(E0v_, k_); E = w_ & 0xffff; C = w_ >> 16; HAS = true; } \
        else if (bm1_) { const int k_ = __ffsll((long long)bm1_) - 1; bm1_ &= bm1_ - 1; const int w_ = __builtin_amdgcn_readlane(E1v_, k_); E = w_ & 0xffff; C = w_ >> 16; HAS = true; }
#define VS_MAC4(ACC) _Pragma("unroll") for (int i_ = 0; i_ < 2; ++i_) _Pragma("unroll") for (int w_ = 0; w_ < 4; ++w_) { \
                const unsigned ablo_ = __builtin_amdgcn_perm(xb_[i_][w_], xa_[i_][w_], 0x05010400u), abhi_ = __builtin_amdgcn_perm(xb_[i_][w_], xa_[i_][w_], 0x07030602u); \
                const unsigned cdlo_ = __builtin_amdgcn_perm(xd_[i_][w_], xc_[i_][w_], 0x05010400u), cdhi_ = __builtin_amdgcn_perm(xd_[i_][w_], xc_[i_][w_], 0x07030602u); \
                ACC[i_][4 * w_ + 0] = __builtin_amdgcn_sdot4((int)__builtin_amdgcn_perm(cdlo_, ablo_, 0x05040100u), coef_, ACC[i_][4 * w_ + 0], false); \
                ACC[i_][4 * w_ + 1] = __builtin_amdgcn_sdot4((int)__builtin_amdgcn_perm(cdlo_, ablo_, 0x07060302u), coef_, ACC[i_][4 * w_ + 1], false); \
                ACC[i_][4 * w_ + 2] = __builtin_amdgcn_sdot4((int)__builtin_amdgcn_perm(cdhi_, abhi_, 0x05040100u), coef_, ACC[i_][4 * w_ + 2], false); \
                ACC[i_][4 * w_ + 3] = __builtin_amdgcn_sdot4((int)__builtin_amdgcn_perm(cdhi_, abhi_, 0x07060302u), coef_, ACC[i_][4 * w_ + 3], false); }
#define VS_ROWS4F(ACC, E0, E1, P0, P1) do { const int E0v_ = (E0), E1v_ = (E1); \
          \
        const unsigned long long av0_ = __ballot(((E0v_ >> 10) & 63) <= s) & (P0), av1_ = __ballot(((E1v_ >> 10) & 63) <= s) & (P1); unsigned long long bm0_ = av0_, bm1_ = av1_; \
        for (int nt_ = (__builtin_popcountll(av0_) + __builtin_popcountll(av1_)) >> 2; nt_ > 0; --nt_) { VS_TAKE(ea_, ca_, ha_) VS_TAKE(eb_, cb_, hb_) VS_TAKE(ec_, cc_, hc_) VS_TAKE(ed_, cd_, hd_)     \
            const int coef_ = (ca_ & 255) | ((cb_ & 255) << 8) | ((cc_ & 255) << 16) | (cd_ << 24); \
            u32x4g xa_[2], xb_[2], xc_[2], xd_[2]; \
            { const unsigned char* r_ = vsb + (size_t)ea_ * DM + l16; _Pragma("unroll") for (int i_ = 0; i_ < 2; ++i_) xa_[i_] = *(const u32x4g*)(r_ + i_ * 1024); } \
            { const unsigned char* r_ = vsb + (size_t)eb_ * DM + l16; _Pragma("unroll") for (int i_ = 0; i_ < 2; ++i_) xb_[i_] = *(const u32x4g*)(r_ + i_ * 1024); } \
            { const unsigned char* r_ = vsb + (size_t)ec_ * DM + l16; _Pragma("unroll") for (int i_ = 0; i_ < 2; ++i_) xc_[i_] = *(const u32x4g*)(r_ + i_ * 1024); } \
            { const unsigned char* r_ = vsb + (size_t)ed_ * DM + l16; _Pragma("unroll") for (int i_ = 0; i_ < 2; ++i_) xd_[i_] = *(const u32x4g*)(r_ + i_ * 1024); } \
            VS_MAC4(ACC) } \
        (P0) ^= av0_ ^ bm0_; (P1) ^= av1_ ^ bm1_; } while (0)
#define VS_ROWS4L(ACC, E0, E1, P0, P1) do { const int E0v_ = (E0), E1v_ = (E1);     \
        unsigned long long bm0_ = (P0), bm1_ = (P1); \
        while (bm0_ | bm1_) { VS_TAKE(ea_, ca_, ha_) VS_TAKE(eb_, cb_, hb_) VS_TAKE(ec_, cc_, hc_) VS_TAKE(ed_, cd_, hd_) \
            const int coef_ = (ca_ & 255) | ((cb_ & 255) << 8) | ((cc_ & 255) << 16) | (cd_ << 24); \
            u32x4g xa_[2], xb_[2], xc_[2], xd_[2]; \
            _Pragma("unroll") for (int i_ = 0; i_ < 2; ++i_) { xa_[i_] = (u32x4g){0u, 0u, 0u, 0u}; xb_[i_] = xa_[i_]; xc_[i_] = xa_[i_]; xd_[i_] = xa_[i_]; } \
            { const unsigned char* r_ = vsb + (size_t)ea_ * DM + l16; _Pragma("unroll") for (int i_ = 0; i_ < 2; ++i_) xa_[i_] = *(const u32x4g*)(r_ + i_ * 1024); } \
            if (hb_) { const unsigned char* r_ = vsb + (size_t)eb_ * DM + l16; _Pragma("unroll") for (int i_ = 0; i_ < 2; ++i_) xb_[i_] = *(const u32x4g*)(r_ + i_ * 1024); } \
            if (hc_) { const unsigned char* r_ = vsb + (size_t)ec_ * DM + l16; _Pragma("unroll") for (int i_ = 0; i_ < 2; ++i_) xc_[i_] = *(const u32x4g*)(r_ + i_ * 1024); } \
            if (hd_) { const unsigned char* r_ = vsb + (size_t)ed_ * DM + l16; _Pragma("unroll") for (int i_ = 0; i_ < 2; ++i_) xd_[i_] = *(const u32x4g*)(r_ + i_ * 1024); } \
            VS_MAC4(ACC) } } while (0)
#define VS_TOKEN(X, t) const float rs##X = rstd_of(ssq, t, lane) * HS[t]; const int e##X##0 = EIDX[(size_t)(t) * PK + lane], e##X##1 = EIDX[(size_t)(t) * PK + 64 + lane]; \
        const float a##X##0 = gelu_erf((float)D[(size_t)(t) * PK + lane] * US[e##X##0] * rs##X) * GATE[(size_t)(t) * PK + lane] * VS[e##X##0], a##X##1 = gelu_erf((float)D[(size_t)(t) * PK + 64 + lane] * US[e##X##1] * rs##X) * GATE[(size_t)(t) * PK + 64 + lane] * VS[e##X##1]; \
        const float m##X = wave_max(fmaxf(fabsf(a##X##0), fabsf(a##X##1))); const float i##X = m##X > 0.f ? 127.f / m##X : 0.f; const int c##X##0 = __float2int_rn(a##X##0 * i##X), c##X##1 = __float2int_rn(a##X##1 * i##X);
#define VS_STORE(ACC, X, t) do { const float sc_ = m##X * (1.f / 127.f); float* o_ = out + (size_t)(t) * DM + ph * 2048 + lane * 16; \
        _Pragma("unroll") for (int i_ = 0; i_ < 2; ++i_) _Pragma("unroll") for (int w_ = 0; w_ < 4; ++w_) { float4 q_ = *(float4*)(o_ + i_ * 1024 + 4 * w_); \
            q_.x += sc_ * (float)ACC[i_][4 * w_]; q_.y += sc_ * (float)ACC[i_][4 * w_ + 1]; q_.z += sc_ * (float)ACC[i_][4 * w_ + 2]; q_.w += sc_ * (float)ACC[i_][4 * w_ + 3]; *(float4*)(o_ + i_ * 1024 + 4 * w_) = q_; } } while (0)
__device__ __forceinline__ void phase_vsum2(const int* __restrict__ D, const float* __restrict__ HS, const float* __restrict__ ssq, const int* __restrict__ EIDX, const float* __restrict__ GATE,
                                            const unsigned char* __restrict__ V8, const float* __restrict__ US, const float* __restrict__ VS, float* __restrict__ out, int vcu, int G) {
    const int lane = threadIdx.x & 63, gw = vcu * 8 + __builtin_amdgcn_readfirstlane(threadIdx.x >> 6), NGW = G * 8;
    for (int t0 = 4 * gw; t0 < S; t0 += 4 * NGW) {
        VS_TOKEN(A, t0) VS_TOKEN(B, t0 + 1) VS_TOKEN(C, t0 + 2) VS_TOKEN(E, t0 + 3)
        const int kA0 = eA0 | (cA0 << 16), kA1 = eA1 | (cA1 << 16), kB0 = eB0 | (cB0 << 16), kB1 = eB1 | (cB1 << 16), kC0 = eC0 | (cC0 << 16), kC1 = eC1 | (cC1 << 16), kE0 = eE0 | (cE0 << 16), kE1 = eE1 | (cE1 << 16);
#pragma unroll 1
        for (int ph = 0; ph < 2; ++ph) { const unsigned char* vsb = V8 + ph * 2048; const unsigned l16 = lane * 16;
            int accA[2][16], accB[2][16], accC[2][16], accE[2][16];
#pragma unroll
            for (int i = 0; i < 2; ++i)
#pragma unroll
                for (int j = 0; j < 16; ++j) { accA[i][j] = 0; accB[i][j] = 0; accC[i][j] = 0; accE[i][j] = 0; }
            unsigned long long pA0 = ~0ull, pA1 = ~0ull, pB0 = ~0ull, pB1 = ~0ull, pC0 = ~0ull, pC1 = ~0ull, pE0 = ~0ull, pE1 = ~0ull;
#pragma unroll 1
            for (int s = 0; s < NEXP / 1024 - 1; ++s) { VS_ROWS4F(accA, kA0, kA1, pA0, pA1); VS_ROWS4F(accB, kB0, kB1, pB0, pB1); VS_ROWS4F(accC, kC0, kC1, pC0, pC1); VS_ROWS4F(accE, kE0, kE1, pE0, pE1); }
            VS_ROWS4L(accA, kA0, kA1, pA0, pA1); VS_ROWS4L(accB, kB0, kB1, pB0, pB1); VS_ROWS4L(accC, kC0, kC1, pC0, pC1); VS_ROWS4L(accE, kE0, kE1, pE0, pE1);
            VS_STORE(accA, A, t0); VS_STORE(accB, B, t0 + 1); VS_STORE(accC, C, t0 + 2); VS_STORE(accE, E, t0 + 3);
        }
    }
}
}
namespace pg8 {
#define PG8_LAS __attribute__((address_space(3)))
typedef short bf16x8 __attribute__((ext_vector_type(8)));
typedef float f32x4 __attribute__((ext_vector_type(4)));
typedef unsigned u32x4 __attribute__((ext_vector_type(4)));
typedef unsigned u32x2 __attribute__((ext_vector_type(2)));
#ifndef G1_WGM
#define G1_WGM 8
#endif
constexpr int BM = 256, BK = 64, HALF = 128, HTB = HALF * BK * 2, STAGE_BYTES = 8 * HTB, NXCD = 8, WGM = 8;
__device__ __forceinline__ int lds_byte(int r, int c) { const int st = (r >> 4) * 2 + (c >> 5), rr = r & 15, cc = c & 31, ob = rr * 64 + cc * 2; return st * 1024 + (ob ^ (((ob >> 9) & 1) << 5)); }
__device__ __forceinline__ void stage_rc(int b, int& R, int& C) { const int st = b / 1024, sb = b % 1024, swz = sb ^ (((sb >> 9) & 1) << 5); R = (st >> 1) * 16 + swz / 64; C = (st & 1) * 32 + (swz % 64) / 2; }
__device__ __forceinline__ int perm32(int rho) { const int n = rho >> 4, i = rho & 15; return 8 * (i >> 2) + 4 * n + (i & 3); }
typedef __bf16 bf16x2_t __attribute__((ext_vector_type(2)));
typedef float f32x2_t __attribute__((ext_vector_type(2)));
__device__ __forceinline__ unsigned cvt_pk_bf16(float lo, float hi) { return __builtin_bit_cast(unsigned, __builtin_convertvector((f32x2_t){lo, hi}, bf16x2_t)); }

struct Tile { const char* A; const char* B; int nt, pm, pn, kind, seq; };
template <int WGMT = WGM> __device__ __forceinline__ void static_order(int L, int nM, int nN, int& pm, int& pn) {
    const int nwg = nM * nN; int wgid = L; { const int q = nwg / NXCD, r = nwg % NXCD, xcd = wgid % NXCD, off = wgid / NXCD; wgid = (xcd < r ? xcd * (q + 1) : r * (q + 1) + (xcd - r) * q) + off; }
    const int nig = WGMT * nN, gid = wgid / nig, fm = gid * WGMT, gsz = (nM - fm) < WGMT ? (nM - fm) : WGMT;
    pm = fm + ((wgid % nig) % gsz); pn = (wgid % nig) / gsz;
}
typedef int i32x4 __attribute__((ext_vector_type(4)));
template <bool I8> __device__ __forceinline__ f32x4 mma16(bf16x8 b, bf16x8 a, f32x4 c) {
    if constexpr (I8) return __builtin_bit_cast(f32x4, __builtin_amdgcn_mfma_i32_16x16x64_i8(__builtin_bit_cast(i32x4, b), __builtin_bit_cast(i32x4, a), __builtin_bit_cast(i32x4, c), 0, 0, 0));
    else return __builtin_amdgcn_mfma_f32_16x16x32_bf16(b, a, c, 0, 0, 0);
}
template <class Epi, class Sched, bool I8 = false>
__device__ __forceinline__ void gemm_phase(PG8_LAS unsigned char* lds, const Sched& S, const Epi& E) {
    const int tid = threadIdx.x, wid = __builtin_amdgcn_readfirstlane(tid >> 6), lane = tid & 63, wr = wid >> 2, wc = wid & 3, fr = lane & 15, fq = lane >> 4;
    unsigned voffA[2], voffB[2];
#pragma unroll
    for (int i = 0; i < 2; ++i) { int R, C; stage_rc(tid * 16 + i * 8192, R, C); const int Rb = (R & ~31) + perm32(R & 31); voffA[i] = (unsigned)R * S.pa + C * 2; voffB[i] = (unsigned)Rb * S.pb + C * 2; }
    const size_t kstep = (size_t)(BK * 2);
    const size_t hsA = (size_t)HALF * S.pa, hsB = (size_t)HALF * S.pb;
    const unsigned ldsw = (unsigned)wid * 1024u;
    const int aoff = lds_byte(wr * 64 + fr, fq * 8), boff = lds_byte(wc * 32 + fr, fq * 8);
#define PG8_SA(b, h) (((b) * 2 + (h)) * HTB)
#define PG8_SB(b, h) ((4 + (b) * 2 + (h)) * HTB)
#define PG8_STAGE(bufoff, gbase, voff) do { _Pragma("unroll") for (int _i = 0; _i < 2; ++_i) \
        __builtin_amdgcn_global_load_lds((const unsigned*)((const char*)(gbase) + (voff)[_i]), (PG8_LAS unsigned*)(lds + (bufoff) + ldsw + _i * 8192), 16, 0, 0); } while (0)
#define PG8_LDA(dst, b, h) do { _Pragma("unroll") for (int m = 0; m < 4; ++m) _Pragma("unroll") for (int k = 0; k < 2; ++k) dst[m][k] = *(const PG8_LAS bf16x8*)(lds + PG8_SA(b, h) + aoff + m * 2048 + k * 1024); } while (0)
#define PG8_LDB(dst, b, h) do { _Pragma("unroll") for (int n = 0; n < 2; ++n) _Pragma("unroll") for (int k = 0; k < 2; ++k) dst[n][k] = *(const PG8_LAS bf16x8*)(lds + PG8_SB(b, h) + boff + n * 2048 + k * 1024); } while (0)
#define PG8_MMA(ai, bj, At, Bt) do { __builtin_amdgcn_s_setprio(1); _Pragma("unroll") for (int m = 0; m < 4; ++m) _Pragma("unroll") for (int n = 0; n < 2; ++n) _Pragma("unroll") for (int k = 0; k < 2; ++k) \
        acc[ai][bj][m][n] = mma16<I8>(Bt[n][k], At[m][k], acc[ai][bj][m][n]); __builtin_amdgcn_s_setprio(0); } while (0)
#define PG8_WAIT_V(n) asm volatile("s_waitcnt vmcnt(" #n ")" ::: "memory")
#define PG8_WAIT_L(n) asm volatile("s_waitcnt lgkmcnt(" #n ")" ::: "memory")
#define PG8_BAR __builtin_amdgcn_s_barrier()
#define PG8_SCHED __builtin_amdgcn_sched_barrier(0)
    Tile cur, nxt; int ui = 0;
    if (!S.next(0, cur)) return;
    f32x4 acc[2][2][4][2];
#pragma unroll
    for (int a = 0; a < 2; ++a)
#pragma unroll
        for (int b = 0; b < 2; ++b)
#pragma unroll
            for (int m = 0; m < 4; ++m)
#pragma unroll
                for (int n = 0; n < 2; ++n) acc[a][b][m][n] = (f32x4){0.f, 0.f, 0.f, 0.f};
    bf16x8 At[4][2], B0[2][2], B1[2][2];
    const char* cA = cur.A; const char* cB = cur.B;
    PG8_STAGE(PG8_SB(0, 0), cB, voffB); PG8_STAGE(PG8_SA(0, 0), cA, voffA); PG8_STAGE(PG8_SB(0, 1), cB + hsB, voffB); PG8_STAGE(PG8_SA(0, 1), cA + hsA, voffA);
    if (wr == 1) PG8_BAR;
    PG8_WAIT_V(4); PG8_BAR;
    PG8_STAGE(PG8_SB(1, 0), cB + kstep, voffB); PG8_STAGE(PG8_SA(1, 0), cA + kstep, voffA); PG8_STAGE(PG8_SB(1, 1), cB + hsB + kstep, voffB);
    PG8_WAIT_V(6); PG8_BAR;
    for (;;) {
        const bool has_next = S.next(ui + 1, nxt);
        const char* nA = has_next ? nxt.A : cA; const char* nB = has_next ? nxt.B : cB;
        const int nt = cur.nt;
        for (int t = 0; t < nt; t += 2) {
            const bool last = (t == nt - 2);
            const char* a1 = cA + (size_t)(t + 1) * kstep;
            const char* a2 = last ? nA : cA + (size_t)(t + 2) * kstep; const char* b2 = last ? nB : cB + (size_t)(t + 2) * kstep;
            const char* a3 = a2 + kstep; const char* b3 = b2 + kstep;
            PG8_LDB(B0, 0, 0); PG8_SCHED; PG8_LDA(At, 0, 0); PG8_STAGE(PG8_SA(1, 1), a1 + hsA, voffA);
            PG8_WAIT_L(8); PG8_BAR; PG8_WAIT_L(0); PG8_MMA(0, 0, At, B0); PG8_BAR; PG8_SCHED;
            PG8_LDB(B1, 0, 1); PG8_STAGE(PG8_SB(0, 0), b2, voffB);
            PG8_BAR; PG8_WAIT_L(0); PG8_MMA(0, 1, At, B1); PG8_BAR;
            PG8_LDA(At, 0, 1); PG8_STAGE(PG8_SA(0, 0), a2, voffA);
            PG8_BAR; PG8_WAIT_L(0); PG8_MMA(1, 0, At, B0); PG8_BAR; PG8_SCHED;
            PG8_STAGE(PG8_SB(0, 1), b2 + hsB, voffB);
            PG8_WAIT_V(6); PG8_BAR; PG8_MMA(1, 1, At, B1); PG8_BAR;
            PG8_LDB(B0, 1, 0); PG8_SCHED; PG8_LDA(At, 1, 0); PG8_STAGE(PG8_SA(0, 1), a2 + hsA, voffA);
            PG8_WAIT_L(8); PG8_BAR; PG8_WAIT_L(0); PG8_MMA(0, 0, At, B0); PG8_BAR; PG8_SCHED;
            PG8_LDB(B1, 1, 1); PG8_STAGE(PG8_SB(1, 0), b3, voffB);
            PG8_BAR; PG8_WAIT_L(0); PG8_MMA(0, 1, At, B1); PG8_BAR;
            PG8_LDA(At, 1, 1); PG8_STAGE(PG8_SA(1, 0), a3, voffA);
            PG8_BAR; PG8_WAIT_L(0); PG8_MMA(1, 0, At, B0); PG8_BAR; PG8_SCHED;
            PG8_STAGE(PG8_SB(1, 1), b3 + hsB, voffB);
            PG8_WAIT_V(6); PG8_BAR; PG8_MMA(1, 1, At, B1); PG8_BAR;
        }
        const bool keep = E(acc, cur, wr, wc, fr, fq, lds + STAGE_BYTES);
        if (!has_next) break;
        if (!keep) {
#pragma unroll
            for (int a = 0; a < 2; ++a)
#pragma unroll
                for (int b = 0; b < 2; ++b)
#pragma unroll
                    for (int m = 0; m < 4; ++m)
#pragma unroll
                        for (int n = 0; n < 2; ++n) acc[a][b][m][n] = (f32x4){0.f, 0.f, 0.f, 0.f};
        }
        cur = nxt; cA = nA; cB = nB; ++ui;
    }
    PG8_WAIT_V(0);
    if (wr == 0) PG8_BAR;
    PG8_BAR;
#undef PG8_SA
#undef PG8_SB
#undef PG8_STAGE
#undef PG8_LDA
#undef PG8_LDB
#undef PG8_MMA
}
#define EPI_BAR() do { asm volatile("s_waitcnt lgkmcnt(0)" ::: "memory"); __builtin_amdgcn_s_barrier(); asm volatile("" ::: "memory"); } while (0)

struct Epi1 {
    unsigned char* ws; const float *XS, *WS8; const float *gqa, *gka, *gqb, *gkb;
    __device__ __forceinline__ bool operator()(f32x4 (&acc)[2][2][4][2], const Tile& u, int wr, int wc, int fr, int fq, PG8_LAS unsigned char* scr) const {
        const int pn = u.pn; size_t boff; int W, ct; const float* gain; float sc = 1.f;
        if (pn < 9) { boff = WS_QA; W = WA; ct = pn; gain = gqa; sc = QSCALE; } else if (pn < 18) { boff = WS_KA; W = WA; ct = pn - 9; gain = gka; }
        else if (pn < 25) { boff = WS_QB; W = WB; ct = pn - 18; gain = gqb; sc = QSCALE; } else { boff = WS_KB; W = WB; ct = pn - 25; gain = gkb; }
        bf16_t* const O = (bf16_t*)(ws + boff);
        const int col0 = ct * 256 + 32 * wc + 8 * fq;
        { const float* wsp = WS8 + pn * 256 + 32 * wc + 8 * fq; f32x4 wsc[2][2]; float xs[2][4];
#pragma unroll
          for (int bj = 0; bj < 2; ++bj) { wsc[bj][0] = *(const f32x4*)(wsp + bj * 128); wsc[bj][1] = *(const f32x4*)(wsp + bj * 128 + 4); }
#pragma unroll
          for (int ai = 0; ai < 2; ++ai)
#pragma unroll
              for (int m = 0; m < 4; ++m) xs[ai][m] = XS[u.pm * 256 + ai * 128 + wr * 64 + m * 16 + fr];
#pragma unroll
          for (int ai = 0; ai < 2; ++ai)
#pragma unroll
              for (int m = 0; m < 4; ++m)
#pragma unroll
                  for (int bj = 0; bj < 2; ++bj)
#pragma unroll
                      for (int h = 0; h < 2; ++h) { const i32x4 a = __builtin_bit_cast(i32x4, acc[ai][bj][m][h]);
#pragma unroll
                          for (int e = 0; e < 4; ++e) acc[ai][bj][m][h][e] = (float)a[e] * xs[ai][m] * wsc[bj][h][e]; } }
        PG8_LAS float* P = (PG8_LAS float*)scr;
#pragma unroll
        for (int ai = 0; ai < 2; ++ai)
#pragma unroll
            for (int m = 0; m < 4; ++m)
#pragma unroll
                for (int bj = 0; bj < 2; ++bj) { const f32x4 a = acc[ai][bj][m][0], b = acc[ai][bj][m][1];
                    float s = (a[0] * a[0] + a[1] * a[1]) + (a[2] * a[2] + a[3] * a[3]) + (b[0] * b[0] + b[1] * b[1]) + (b[2] * b[2] + b[3] * b[3]);
                    s += __shfl_xor(s, 16); s += __shfl_xor(s, 32);
                    if (fq == 0) P[((ai * 128 + wr * 64 + m * 16 + fr) * 2 + bj) * 4 + wc] = s; }
        EPI_BAR();
        const f32x4 g0 = *(const f32x4*)(gain + 32 * wc + 8 * fq) * sc, g1 = *(const f32x4*)(gain + 32 * wc + 8 * fq + 4) * sc;
#pragma unroll
        for (int ai = 0; ai < 2; ++ai)
#pragma unroll
            for (int m = 0; m < 4; ++m) { const int r = ai * 128 + wr * 64 + m * 16 + fr; bf16_t* rowp = O + (size_t)(u.pm * 256 + r) * W + col0;
#pragma unroll
                for (int bj = 0; bj < 2; ++bj) { const f32x4 p = *(const PG8_LAS f32x4*)(P + (r * 2 + bj) * 4);
                    const float rstd = rsqrtf(((p[0] + p[1]) + (p[2] + p[3])) * (1.f / HD) + EPS);
                    const f32x4 v0 = acc[ai][bj][m][0] * rstd * g0, v1 = acc[ai][bj][m][1] * rstd * g1;
                    u32x4 w; w.x = cvt_pk_bf16(v0[0], v0[1]); w.y = cvt_pk_bf16(v0[2], v0[3]); w.z = cvt_pk_bf16(v1[0], v1[1]); w.w = cvt_pk_bf16(v1[2], v1[3]);
                    *(u32x4*)(rowp + bj * 128) = w; } }
        return false;
    }
};
struct Sched1 {
    const char* XN; const char* W; int G, c, nN, nt; unsigned pa, pb;
    __device__ __forceinline__ bool next(int i, Tile& u) const {
        const int L = i * G + c; if (L >= 32 * nN) return false;
        int pm, pn; static_order<G1_WGM>(L, 32, nN, pm, pn); u.seq = L;
        u.nt = nt; u.pm = pm; u.pn = pn; u.A = XN + (size_t)pm * 256 * pa; u.B = W + (size_t)pn * 256 * pb;
        u.kind = 0;
        return true;
    }
};
struct EpiGate8 {
    unsigned char* ws; const float *XS, *WS8;
    __device__ __forceinline__ bool operator()(f32x4 (&acc)[2][2][4][2], const Tile& u, int wr, int wc, int fr, int fq, PG8_LAS unsigned char*) const {
        const int pn = u.pn; const bool sig = pn >= 16; int W, ct; size_t boff;
        if (pn < 9) { W = WA * 2; ct = pn; boff = WS_VAN; } else if (pn < 16) { W = WB * 2; ct = pn - 9; boff = WS_VBN; } else if (pn < 32) { W = DM; ct = pn - 16; boff = WS_GA; } else { W = DM; ct = pn - 32; boff = WS_GB; }
        unsigned char* const obase = ws + boff;
        const int col0 = ct * 256 + 32 * wc + 8 * fq; const float* wsp = WS8 + pn * 256 + 32 * wc + 8 * fq; const float fac = sig ? -LOG2E : 1.f; const float lo8 = pn >= 32 ? 1.f : 0.f;
        f32x4 wsc[2][2];
#pragma unroll
        for (int bj = 0; bj < 2; ++bj) { wsc[bj][0] = *(const f32x4*)(wsp + bj * 128) * fac; wsc[bj][1] = *(const f32x4*)(wsp + bj * 128 + 4) * fac; }
        float xsv[2][4];
#pragma unroll
        for (int ai = 0; ai < 2; ++ai)
#pragma unroll
            for (int m = 0; m < 4; ++m) xsv[ai][m] = XS[u.pm * 256 + ai * 128 + wr * 64 + m * 16 + fr];
        asm volatile("" ::: "memory");
#pragma unroll
        for (int ai = 0; ai < 2; ++ai)
#pragma unroll
            for (int m = 0; m < 4; ++m) { const int row = u.pm * 256 + ai * 128 + wr * 64 + m * 16 + fr; const float xs = xsv[ai][m];
#pragma unroll
                for (int bj = 0; bj < 2; ++bj) { const i32x4 a0 = __builtin_bit_cast(i32x4, acc[ai][bj][m][0]), a1 = __builtin_bit_cast(i32x4, acc[ai][bj][m][1]); f32x4 v0, v1;
#pragma unroll
                    for (int e = 0; e < 4; ++e) { v0[e] = (float)a0[e] * xs * wsc[bj][0][e]; v1[e] = (float)a1[e] * xs * wsc[bj][1][e]; }
                    if (sig) { unsigned lo = 0, hi = 0;
#pragma unroll
                        for (int e = 0; e < 4; ++e) { const float s0 = fmaxf(255.f * __builtin_amdgcn_rcpf(1.f + __builtin_amdgcn_exp2f(v0[e])), lo8), s1 = fmaxf(255.f * __builtin_amdgcn_rcpf(1.f + __builtin_amdgcn_exp2f(v1[e])), lo8);
                            lo |= (unsigned)__float2int_rn(s0) << (8 * e); hi |= (unsigned)__float2int_rn(s1) << (8 * e); }
                        *(u32x2*)(obase + (size_t)row * W + col0 + bj * 128) = (u32x2){lo, hi};
                    } else { bf16_t* rowp = (bf16_t*)(obase + (size_t)row * W) + col0;
                        u32x4 w; w.x = cvt_pk_bf16(v0[0], v0[1]); w.y = cvt_pk_bf16(v0[2], v0[3]); w.z = cvt_pk_bf16(v1[0], v1[1]); w.w = cvt_pk_bf16(v1[2], v1[3]);
                        *(u32x4*)(rowp + bj * 128) = w; } } }
        return false;
    }
};
__device__ __forceinline__ float ub2f(unsigned w, int b) { return (float)((w >> (8 * b)) & 255u); }
struct EpiUp {
    const unsigned char *GA, *GB; bf16_t* MG;
    __device__ __forceinline__ bool operator()(f32x4 (&acc)[2][2][4][2], const Tile& u, int wr, int wc, int fr, int fq, PG8_LAS unsigned char*) const {
        const int col0 = u.pn * 256 + 32 * wc + 8 * fq; const size_t ro0 = (size_t)(u.pm * 256 + wr * 64 + fr) * DM + col0;
        if (u.kind == 0) {
#pragma unroll
            for (int ai = 0; ai < 2; ++ai) {
                u32x2 gav[4][2], gbv[4][2];
#pragma unroll
                for (int m = 0; m < 4; ++m)
#pragma unroll
                    for (int bj = 0; bj < 2; ++bj) { gav[m][bj] = *(const u32x2*)(GA + ro0 + (size_t)(ai * 128 + m * 16) * DM + bj * 128); gbv[m][bj] = *(const u32x2*)(GB + ro0 + (size_t)(ai * 128 + m * 16) * DM + bj * 128); }
                asm volatile("" ::: "memory");
#pragma unroll
                for (int m = 0; m < 4; ++m)
#pragma unroll
                    for (int bj = 0; bj < 2; ++bj) { const u32x2 ga = gav[m][bj], gb = gbv[m][bj];
#pragma unroll
                        for (int e = 0; e < 4; ++e) { acc[ai][bj][m][0][e] *= ub2f(ga.x, e) * __builtin_amdgcn_rcpf(ub2f(gb.x, e)); acc[ai][bj][m][1][e] *= ub2f(ga.y, e) * __builtin_amdgcn_rcpf(ub2f(gb.y, e)); } }
            }
            return true;
        }
#pragma unroll
        for (int ai = 0; ai < 2; ++ai) {
            u32x2 gbv[4][2];
#pragma unroll
            for (int m = 0; m < 4; ++m)
#pragma unroll
                for (int bj = 0; bj < 2; ++bj) gbv[m][bj] = *(const u32x2*)(GB + ro0 + (size_t)(ai * 128 + m * 16) * DM + bj * 128);
            asm volatile("" ::: "memory");
#pragma unroll
            for (int m = 0; m < 4; ++m)
#pragma unroll
                for (int bj = 0; bj < 2; ++bj) { const u32x2 gb = gbv[m][bj]; f32x4 t0, t1;
#pragma unroll
                    for (int e = 0; e < 4; ++e) { t0[e] = acc[ai][bj][m][0][e] * (ub2f(gb.x, e) * (1.f / 255.f)); t1[e] = acc[ai][bj][m][1][e] * (ub2f(gb.y, e) * (1.f / 255.f)); }
                    u32x4 w; w.x = cvt_pk_bf16(t0[0], t0[1]); w.y = cvt_pk_bf16(t0[2], t0[3]); w.z = cvt_pk_bf16(t1[0], t1[1]); w.w = cvt_pk_bf16(t1[2], t1[3]);
                    *(u32x4*)(MG + ro0 + (size_t)(ai * 128 + m * 16) * DM + bj * 128) = w; }
            asm volatile("" ::: "memory");
        }
        return false;
    }
};
struct SchedUp {
    const char* Y; const char* WUT; int G, c; unsigned pa, pb;
    __device__ __forceinline__ bool next(int i, Tile& u) const {
        const int L = (i >> 1) * G + c; if (L >= 512) return false;
        int pm, pn; static_order(L, 32, 16, pm, pn); const int seg = i & 1;
        u.pm = pm; u.pn = pn; u.kind = seg; u.nt = seg ? WB / BK : WAO / BK;
        u.A = Y + (size_t)pm * 256 * (YW * 2) + (seg ? WAO * 2 : 0); u.B = WUT + (size_t)pn * 256 * (YW * 2) + (seg ? WAO * 2 : 0);
        return true;
    }
};
struct EpiOut {
    const float *x, *g2; float* H; bf16_t* XN2; float* SSQ;
    __device__ __forceinline__ bool operator()(f32x4 (&acc)[2][2][4][2], const Tile& u, int wr, int wc, int fr, int fq, PG8_LAS unsigned char*) const {
        const int col0 = u.pn * 256 + 32 * wc + 8 * fq;
        f32x4 gg[2][2];
#pragma unroll
        for (int bj = 0; bj < 2; ++bj) { gg[bj][0] = *(const f32x4*)(g2 + col0 + bj * 128); gg[bj][1] = *(const f32x4*)(g2 + col0 + bj * 128 + 4); }
#pragma unroll
        for (int ai = 0; ai < 2; ++ai)
#pragma unroll
        for (int mh = 0; mh < 2; ++mh) {
            f32x4 xv[2][2][2];
#pragma unroll
            for (int m2 = 0; m2 < 2; ++m2)
#pragma unroll
                for (int bj = 0; bj < 2; ++bj) { const size_t ro = (size_t)(u.pm * 256 + ai * 128 + wr * 64 + (mh * 2 + m2) * 16 + fr) * DM + col0 + bj * 128; xv[m2][bj][0] = *(const f32x4*)(x + ro); xv[m2][bj][1] = *(const f32x4*)(x + ro + 4); }
            asm volatile("" ::: "memory");
#pragma unroll
            for (int m2 = 0; m2 < 2; ++m2) { const int m = mh * 2 + m2; const int row = u.pm * 256 + ai * 128 + wr * 64 + m * 16 + fr; const size_t ro = (size_t)row * DM + col0; float ss = 0.f;
#pragma unroll
                for (int bj = 0; bj < 2; ++bj) { const f32x4 h0 = xv[m2][bj][0] + acc[ai][bj][m][0], h1 = xv[m2][bj][1] + acc[ai][bj][m][1];
                    *(f32x4*)(H + ro + bj * 128) = h0; *(f32x4*)(H + ro + bj * 128 + 4) = h1;
                    ss += (h0[0] * h0[0] + h0[1] * h0[1]) + (h0[2] * h0[2] + h0[3] * h0[3]) + (h1[0] * h1[0] + h1[1] * h1[1]) + (h1[2] * h1[2] + h1[3] * h1[3]);
                    const f32x4 a = h0 * gg[bj][0], b = h1 * gg[bj][1];
                    u32x4 w; w.x = cvt_pk_bf16(a[0], a[1]); w.y = cvt_pk_bf16(a[2], a[3]); w.z = cvt_pk_bf16(b[0], b[1]); w.w = cvt_pk_bf16(b[2], b[3]);
                    *(u32x4*)(XN2 + ro + bj * 128) = w; }
                ss += __shfl_xor(ss, 16); ss += __shfl_xor(ss, 32);
                if (fq == 0) SSQ[row * 64 + u.pn * 4 + wc] = ss; }
            asm volatile("" ::: "memory");
        }
        return false;
    }
};
struct EpiHiLo {
    bf16_t *H, *L; int ldc, pad;
    __device__ __forceinline__ bool operator()(f32x4 (&acc)[2][2][4][2], const Tile& u, int wr, int wc, int fr, int fq, PG8_LAS unsigned char*) const {
        const int col0 = u.pn * 256 + 32 * wc + 8 * fq;
#pragma unroll
        for (int ai = 0; ai < 2; ++ai)
#pragma unroll
            for (int m = 0; m < 4; ++m) { const size_t ro = (size_t)(u.pm * 256 + ai * 128 + wr * 64 + m * 16 + fr) * ldc + col0;
#pragma unroll
                for (int bj = 0; bj < 2; ++bj) { u32x4 wh, wl;
#pragma unroll
                    for (int e = 0; e < 4; ++e) { const float a = acc[ai][bj][m][e >> 1][2 * (e & 1)], b = acc[ai][bj][m][e >> 1][2 * (e & 1) + 1];
                        const unsigned hp = cvt_pk_bf16(a, b); wh[e] = hp; wl[e] = cvt_pk_bf16(a - __uint_as_float(hp << 16), b - __uint_as_float(hp & 0xffff0000u)); }
                    *(u32x4*)(H + ro + bj * 128) = wh; *(u32x4*)(L + ro + bj * 128) = wl; } }
        return false;
    }
};
struct EpiNull { int kp, pad; __device__ __forceinline__ bool operator()(f32x4 (&acc)[2][2][4][2], const Tile& u, int, int, int, int, PG8_LAS unsigned char*) const {
        float s = 0.f;
#pragma unroll
        for (int a = 0; a < 2; ++a)
#pragma unroll
            for (int b = 0; b < 2; ++b)
#pragma unroll
                for (int m = 0; m < 4; ++m)
#pragma unroll
                    for (int n = 0; n < 2; ++n) s += acc[a][b][m][n][0] + acc[a][b][m][n][1] + acc[a][b][m][n][2] + acc[a][b][m][n][3];
        if (s == 1.2345e33f) *(float*)u.A = s;
        return kp && u.kind == 0; } };
struct SchedPlain {
    const char* A; const char* B; int G, c, nM, nN, K; unsigned pa, pb;
    __device__ __forceinline__ bool next(int i, Tile& u) const {
        const int L = i * G + c; if (L >= nM * nN) return false;
        int pm, pn; static_order(L, nM, nN, pm, pn);
        u.pm = pm; u.pn = pn; u.kind = 0; u.nt = K / BK; u.A = A + (size_t)pm * 256 * pa; u.B = B + (size_t)pn * 256 * pb;
        return true;
    }
};
}
namespace tk {
typedef short bf16x8 __attribute__((ext_vector_type(8)));
typedef float f32x16 __attribute__((ext_vector_type(16)));
typedef float f32x4 __attribute__((ext_vector_type(4)));
typedef unsigned u32x4 __attribute__((ext_vector_type(4)));
__device__ __forceinline__ unsigned f2key(float f) { const unsigned b = __float_as_uint(f); return b ^ ((unsigned)((int)b >> 31) | 0x80000000u); }
__device__ __forceinline__ float key2f(unsigned u) { return __uint_as_float(u ^ (~(unsigned)((int)u >> 31) | 0x80000000u)); }
__device__ __forceinline__ unsigned umax(unsigned a, unsigned b) { return a > b ? a : b; }
__device__ __forceinline__ unsigned umin(unsigned a, unsigned b) { return a < b ? a : b; }
#define TK_CE(x, y) do { const unsigned lo_ = umin(x, y), hi_ = umax(x, y); x = hi_; y = lo_; } while (0)
__device__ __forceinline__ void sort16_desc(unsigned (&a)[16]) {
    TK_CE(a[0], a[1]);
    TK_CE(a[3], a[2]);
    TK_CE(a[4], a[5]);
    TK_CE(a[7], a[6]);
    TK_CE(a[8], a[9]);
    TK_CE(a[11], a[10]);
    TK_CE(a[12], a[13]);
    TK_CE(a[15], a[14]);
    TK_CE(a[0], a[2]);
    TK_CE(a[1], a[3]);
    TK_CE(a[6], a[4]);
    TK_CE(a[7], a[5]);
    TK_CE(a[8], a[10]);
    TK_CE(a[9], a[11]);
    TK_CE(a[14], a[12]);
    TK_CE(a[15], a[13]);
    TK_CE(a[0], a[1]);
    TK_CE(a[2], a[3]);
    TK_CE(a[5], a[4]);
    TK_CE(a[7], a[6]);
    TK_CE(a[8], a[9]);
    TK_CE(a[10], a[11]);
    TK_CE(a[13], a[12]);
    TK_CE(a[15], a[14]);
    TK_CE(a[0], a[4]);
    TK_CE(a[1], a[5]);
    TK_CE(a[2], a[6]);
    TK_CE(a[3], a[7]);
    TK_CE(a[12], a[8]);
    TK_CE(a[13], a[9]);
    TK_CE(a[14], a[10]);
    TK_CE(a[15], a[11]);
    TK_CE(a[0], a[2]);
    TK_CE(a[1], a[3]);
    TK_CE(a[4], a[6]);
    TK_CE(a[5], a[7]);
    TK_CE(a[10], a[8]);
    TK_CE(a[11], a[9]);
    TK_CE(a[14], a[12]);
    TK_CE(a[15], a[13]);
    TK_CE(a[0], a[1]);
    TK_CE(a[2], a[3]);
    TK_CE(a[4], a[5]);
    TK_CE(a[6], a[7]);
    TK_CE(a[9], a[8]);
    TK_CE(a[11], a[10]);
    TK_CE(a[13], a[12]);
    TK_CE(a[15], a[14]);
    TK_CE(a[0], a[8]);
    TK_CE(a[1], a[9]);
    TK_CE(a[2], a[10]);
    TK_CE(a[3], a[11]);
    TK_CE(a[4], a[12]);
    TK_CE(a[5], a[13]);
    TK_CE(a[6], a[14]);
    TK_CE(a[7], a[15]);
    TK_CE(a[0], a[4]);
    TK_CE(a[1], a[5]);
    TK_CE(a[2], a[6]);
    TK_CE(a[3], a[7]);
    TK_CE(a[8], a[12]);
    TK_CE(a[9], a[13]);
    TK_CE(a[10], a[14]);
    TK_CE(a[11], a[15]);
    TK_CE(a[0], a[2]);
    TK_CE(a[1], a[3]);
    TK_CE(a[4], a[6]);
    TK_CE(a[5], a[7]);
    TK_CE(a[8], a[10]);
    TK_CE(a[9], a[11]);
    TK_CE(a[12], a[14]);
    TK_CE(a[13], a[15]);
    TK_CE(a[0], a[1]);
    TK_CE(a[2], a[3]);
    TK_CE(a[4], a[5]);
    TK_CE(a[6], a[7]);
    TK_CE(a[8], a[9]);
    TK_CE(a[10], a[11]);
    TK_CE(a[12], a[13]);
    TK_CE(a[14], a[15]);
}
__device__ __forceinline__ void merge_top16(unsigned (&a)[16], const unsigned (&b)[16]) {
    a[0] = umax(a[0], b[15]);
    a[1] = umax(a[1], b[14]);
    a[2] = umax(a[2], b[13]);
    a[3] = umax(a[3], b[12]);
    a[4] = umax(a[4], b[11]);
    a[5] = umax(a[5], b[10]);
    a[6] = umax(a[6], b[9]);
    a[7] = umax(a[7], b[8]);
    a[8] = umax(a[8], b[7]);
    a[9] = umax(a[9], b[6]);
    a[10] = umax(a[10], b[5]);
    a[11] = umax(a[11], b[4]);
    a[12] = umax(a[12], b[3]);
    a[13] = umax(a[13], b[2]);
    a[14] = umax(a[14], b[1]);
    a[15] = umax(a[15], b[0]);
    TK_CE(a[0], a[8]);
    TK_CE(a[1], a[9]);
    TK_CE(a[2], a[10]);
    TK_CE(a[3], a[11]);
    TK_CE(a[4], a[12]);
    TK_CE(a[5], a[13]);
    TK_CE(a[6], a[14]);
    TK_CE(a[7], a[15]);
    TK_CE(a[0], a[4]);
    TK_CE(a[1], a[5]);
    TK_CE(a[2], a[6]);
    TK_CE(a[3], a[7]);
    TK_CE(a[8], a[12]);
    TK_CE(a[9], a[13]);
    TK_CE(a[10], a[14]);
    TK_CE(a[11], a[15]);
    TK_CE(a[0], a[2]);
    TK_CE(a[1], a[3]);
    TK_CE(a[4], a[6]);
    TK_CE(a[5], a[7]);
    TK_CE(a[8], a[10]);
    TK_CE(a[9], a[11]);
    TK_CE(a[12], a[14]);
    TK_CE(a[13], a[15]);
    TK_CE(a[0], a[1]);
    TK_CE(a[2], a[3]);
    TK_CE(a[4], a[5]);
    TK_CE(a[6], a[7]);
    TK_CE(a[8], a[9]);
    TK_CE(a[10], a[11]);
    TK_CE(a[12], a[13]);
    TK_CE(a[14], a[15]);
}
#define TK_CE2(i, l) do { const bool sw_ = k[i] < k[l]; const unsigned k0_ = sw_ ? k[l] : k[i], k1_ = sw_ ? k[i] : k[l], p0_ = sw_ ? p[l] : p[i], p1_ = sw_ ? p[i] : p[l]; k[i] = k0_; k[l] = k1_; p[i] = p0_; p[l] = p1_; } while (0)
__device__ __forceinline__ void sort16_desc2(unsigned (&k)[16], unsigned (&p)[16]) {
    TK_CE2(0, 1);
    TK_CE2(3, 2);
    TK_CE2(4, 5);
    TK_CE2(7, 6);
    TK_CE2(8, 9);
    TK_CE2(11, 10);
    TK_CE2(12, 13);
    TK_CE2(15, 14);
    TK_CE2(0, 2);
    TK_CE2(1, 3);
    TK_CE2(6, 4);
    TK_CE2(7, 5);
    TK_CE2(8, 10);
    TK_CE2(9, 11);
    TK_CE2(14, 12);
    TK_CE2(15, 13);
    TK_CE2(0, 1);
    TK_CE2(2, 3);
    TK_CE2(5, 4);
    TK_CE2(7, 6);
    TK_CE2(8, 9);
    TK_CE2(10, 11);
    TK_CE2(13, 12);
    TK_CE2(15, 14);
    TK_CE2(0, 4);
    TK_CE2(1, 5);
    TK_CE2(2, 6);
    TK_CE2(3, 7);
    TK_CE2(12, 8);
    TK_CE2(13, 9);
    TK_CE2(14, 10);
    TK_CE2(15, 11);
    TK_CE2(0, 2);
    TK_CE2(1, 3);
    TK_CE2(4, 6);
    TK_CE2(5, 7);
    TK_CE2(10, 8);
    TK_CE2(11, 9);
    TK_CE2(14, 12);
    TK_CE2(15, 13);
    TK_CE2(0, 1);
    TK_CE2(2, 3);
    TK_CE2(4, 5);
    TK_CE2(6, 7);
    TK_CE2(9, 8);
    TK_CE2(11, 10);
    TK_CE2(13, 12);
    TK_CE2(15, 14);
    TK_CE2(0, 8);
    TK_CE2(1, 9);
    TK_CE2(2, 10);
    TK_CE2(3, 11);
    TK_CE2(4, 12);
    TK_CE2(5, 13);
    TK_CE2(6, 14);
    TK_CE2(7, 15);
    TK_CE2(0, 4);
    TK_CE2(1, 5);
    TK_CE2(2, 6);
    TK_CE2(3, 7);
    TK_CE2(8, 12);
    TK_CE2(9, 13);
    TK_CE2(10, 14);
    TK_CE2(11, 15);
    TK_CE2(0, 2);
    TK_CE2(1, 3);
    TK_CE2(4, 6);
    TK_CE2(5, 7);
    TK_CE2(8, 10);
    TK_CE2(9, 11);
    TK_CE2(12, 14);
    TK_CE2(13, 15);
    TK_CE2(0, 1);
    TK_CE2(2, 3);
    TK_CE2(4, 5);
    TK_CE2(6, 7);
    TK_CE2(8, 9);
    TK_CE2(10, 11);
    TK_CE2(12, 13);
    TK_CE2(14, 15);
}
__device__ __forceinline__ void merge_top16_2(unsigned (&k)[16], unsigned (&p)[16], const unsigned (&kb)[16], const unsigned (&pb)[16]) {
    { const bool t_ = kb[15] > k[0]; k[0] = t_ ? kb[15] : k[0]; p[0] = t_ ? pb[15] : p[0]; }
    { const bool t_ = kb[14] > k[1]; k[1] = t_ ? kb[14] : k[1]; p[1] = t_ ? pb[14] : p[1]; }
    { const bool t_ = kb[13] > k[2]; k[2] = t_ ? kb[13] : k[2]; p[2] = t_ ? pb[13] : p[2]; }
    { const bool t_ = kb[12] > k[3]; k[3] = t_ ? kb[12] : k[3]; p[3] = t_ ? pb[12] : p[3]; }
    { const bool t_ = kb[11] > k[4]; k[4] = t_ ? kb[11] : k[4]; p[4] = t_ ? pb[11] : p[4]; }
    { const bool t_ = kb[10] > k[5]; k[5] = t_ ? kb[10] : k[5]; p[5] = t_ ? pb[10] : p[5]; }
    { const bool t_ = kb[9] > k[6]; k[6] = t_ ? kb[9] : k[6]; p[6] = t_ ? pb[9] : p[6]; }
    { const bool t_ = kb[8] > k[7]; k[7] = t_ ? kb[8] : k[7]; p[7] = t_ ? pb[8] : p[7]; }
    { const bool t_ = kb[7] > k[8]; k[8] = t_ ? kb[7] : k[8]; p[8] = t_ ? pb[7] : p[8]; }
    { const bool t_ = kb[6] > k[9]; k[9] = t_ ? kb[6] : k[9]; p[9] = t_ ? pb[6] : p[9]; }
    { const bool t_ = kb[5] > k[10]; k[10] = t_ ? kb[5] : k[10]; p[10] = t_ ? pb[5] : p[10]; }
    { const bool t_ = kb[4] > k[11]; k[11] = t_ ? kb[4] : k[11]; p[11] = t_ ? pb[4] : p[11]; }
    { const bool t_ = kb[3] > k[12]; k[12] = t_ ? kb[3] : k[12]; p[12] = t_ ? pb[3] : p[12]; }
    { const bool t_ = kb[2] > k[13]; k[13] = t_ ? kb[2] : k[13]; p[13] = t_ ? pb[2] : p[13]; }
    { const bool t_ = kb[1] > k[14]; k[14] = t_ ? kb[1] : k[14]; p[14] = t_ ? pb[1] : p[14]; }
    { const bool t_ = kb[0] > k[15]; k[15] = t_ ? kb[0] : k[15]; p[15] = t_ ? pb[0] : p[15]; }
    TK_CE2(0, 8);
    TK_CE2(1, 9);
    TK_CE2(2, 10);
    TK_CE2(3, 11);
    TK_CE2(4, 12);
    TK_CE2(5, 13);
    TK_CE2(6, 14);
    TK_CE2(7, 15);
    TK_CE2(0, 4);
    TK_CE2(1, 5);
    TK_CE2(2, 6);
    TK_CE2(3, 7);
    TK_CE2(8, 12);
    TK_CE2(9, 13);
    TK_CE2(10, 14);
    TK_CE2(11, 15);
    TK_CE2(0, 2);
    TK_CE2(1, 3);
    TK_CE2(4, 6);
    TK_CE2(5, 7);
    TK_CE2(8, 10);
    TK_CE2(9, 11);
    TK_CE2(12, 14);
    TK_CE2(13, 15);
    TK_CE2(0, 1);
    TK_CE2(2, 3);
    TK_CE2(4, 5);
    TK_CE2(6, 7);
    TK_CE2(8, 9);
    TK_CE2(10, 11);
    TK_CE2(12, 13);
    TK_CE2(14, 15);
}
#define TK_CAND(slot, who, a, b) do { const unsigned kx_ = f2key(f1[a] + f2[b]), px_ = ((t0[a] & 127u) << 7) | (t1[b] & 127u); \
    if (who == 0) { ck[slot] = hh ? ck[slot] : kx_; cp[slot] = hh ? cp[slot] : px_; } else { ck[slot] = hh ? kx_ : ck[slot]; cp[slot] = hh ? px_ : cp[slot]; } } while (0)
__device__ __forceinline__ void make_cands(const unsigned (&t0)[16], const unsigned (&t1)[16], const float (&f1)[16], const float (&f2)[16], int hh, unsigned (&ck)[32], unsigned (&cp)[32]) {
    TK_CAND(0, 0, 0, 0);
    TK_CAND(0, 1, 0, 1);
    TK_CAND(1, 0, 0, 2);
    TK_CAND(1, 1, 0, 3);
    TK_CAND(2, 0, 0, 4);
    TK_CAND(2, 1, 0, 5);
    TK_CAND(3, 0, 0, 6);
    TK_CAND(3, 1, 0, 7);
    TK_CAND(4, 0, 0, 8);
    TK_CAND(4, 1, 0, 9);
    TK_CAND(5, 0, 0, 10);
    TK_CAND(5, 1, 0, 11);
    TK_CAND(6, 0, 0, 12);
    TK_CAND(6, 1, 0, 13);
    TK_CAND(7, 0, 0, 14);
    TK_CAND(7, 1, 0, 15);
    TK_CAND(8, 0, 1, 0);
    TK_CAND(8, 1, 1, 1);
    TK_CAND(9, 0, 1, 2);
    TK_CAND(9, 1, 1, 3);
    TK_CAND(10, 0, 1, 4);
    TK_CAND(10, 1, 1, 5);
    TK_CAND(11, 0, 1, 6);
    TK_CAND(11, 1, 1, 7);
    TK_CAND(12, 0, 2, 0);
    TK_CAND(12, 1, 2, 1);
    TK_CAND(13, 0, 2, 2);
    TK_CAND(13, 1, 2, 3);
    TK_CAND(14, 0, 2, 4);
    TK_CAND(14, 1, 3, 0);
    TK_CAND(15, 0, 3, 1);
    TK_CAND(15, 1, 3, 2);
    TK_CAND(16, 0, 3, 3);
    TK_CAND(16, 1, 4, 0);
    TK_CAND(17, 0, 4, 1);
    TK_CAND(17, 1, 4, 2);
    TK_CAND(18, 0, 5, 0);
    TK_CAND(18, 1, 5, 1);
    TK_CAND(19, 0, 6, 0);
    TK_CAND(19, 1, 6, 1);
    TK_CAND(20, 0, 7, 0);
    TK_CAND(20, 1, 7, 1);
    TK_CAND(21, 0, 8, 0);
    TK_CAND(21, 1, 9, 0);
    TK_CAND(22, 0, 10, 0);
    TK_CAND(22, 1, 11, 0);
    TK_CAND(23, 0, 12, 0);
    TK_CAND(23, 1, 13, 0);
    TK_CAND(24, 0, 14, 0);
    TK_CAND(24, 1, 15, 0);
}
__device__ __forceinline__ void score_group(const char* kh, const char* kl, unsigned kvo, const bf16x8 (&qh)[8], const bf16x8 (&ql)[8], int ng, int hh, unsigned (&key)[16]) {
    f32x16 sacc;
#pragma unroll
    for (int r = 0; r < 16; ++r) sacc[r] = 0.f;
#pragma unroll
    for (int ks = 0; ks < 8; ++ks) { const bf16x8 ah = *(const bf16x8*)(kh + 32 * ks + kvo), al = *(const bf16x8*)(kl + 32 * ks + kvo);
        sacc = __builtin_amdgcn_mfma_f32_32x32x16_bf16(ah, qh[ks], sacc, 0, 0, 0); sacc = __builtin_amdgcn_mfma_f32_32x32x16_bf16(ah, ql[ks], sacc, 0, 0, 0); sacc = __builtin_amdgcn_mfma_f32_32x32x16_bf16(al, qh[ks], sacc, 0, 0, 0); }
#pragma unroll
    for (int r = 0; r < 16; ++r) key[r] = (f2key(sacc[r]) & ~127u) | (unsigned)(32 * ng + (r & 3) + 8 * (r >> 2) + 4 * hh);
    sort16_desc(key);
    asm volatile("" ::: "memory");
}
__device__ __forceinline__ void select_half(const bf16_t* __restrict__ QH, const bf16_t* __restrict__ QL, const bf16_t* __restrict__ SKH, const bf16_t* __restrict__ SKL, int t0, int h, int c, int tok, int hh, unsigned (&out)[16]) {
    bf16x8 qh[8], ql[8];
    { const char* qr = (const char*)(QH + (size_t)t0 * PQW + h * PQD + c * PQH); const char* qs = (const char*)(QL + (size_t)t0 * PQW + h * PQD + c * PQH); const unsigned qvo = (unsigned)(tok * PQW + 8 * hh) * 2u;
#pragma unroll
      for (int ks = 0; ks < 8; ++ks) { qh[ks] = *(const bf16x8*)(qr + 32 * ks + qvo); ql[ks] = *(const bf16x8*)(qs + 32 * ks + qvo); } }
    const char* kh = (const char*)(SKH + (size_t)(h * 2 + c) * NKEYS * PQH); const char* kl = (const char*)(SKL + (size_t)(h * 2 + c) * NKEYS * PQH); const unsigned kvo = (unsigned)(tok * PQH + 8 * hh) * 2u;
    unsigned k1[16], k2[16], k3[16];
    score_group(kh, kl, kvo, qh, ql, 0, hh, out);
    score_group(kh + 32 * PQH * 2, kl + 32 * PQH * 2, kvo, qh, ql, 1, hh, k1);
    merge_top16(out, k1);
    score_group(kh + 64 * PQH * 2, kl + 64 * PQH * 2, kvo, qh, ql, 2, hh, k2);
    score_group(kh + 96 * PQH * 2, kl + 96 * PQH * 2, kvo, qh, ql, 3, hh, k3);
    merge_top16(k2, k3); merge_top16(out, k2);
#pragma unroll
    for (int i = 0; i < 16; ++i) k1[i] = (unsigned)__shfl_xor((int)out[i], 32);
    merge_top16(out, k1);
}
__device__ __forceinline__ void topk_item(const bf16_t* __restrict__ QH, const bf16_t* __restrict__ QL, const bf16_t* __restrict__ SKH, const bf16_t* __restrict__ SKL, const float* __restrict__ ssq,
                                          int* __restrict__ EIDX, float* __restrict__ GATE, int h, int t0, int tok, int hh) {
        const int t = t0 + tok;
        unsigned top0[16], top1[16];
        select_half(QH, QL, SKH, SKL, t0, h, 0, tok, hh, top0);
        asm volatile("" ::: "memory");
        select_half(QH, QL, SKH, SKL, t0, h, 1, tok, hh, top1);
        float f1[16], f2[16];
#pragma unroll
        for (int i = 0; i < 16; ++i) { f1[i] = key2f(top0[i]); f2[i] = key2f(top1[i]); }
        unsigned ck32[32], cp32[32];
#pragma unroll
        for (int i = 0; i < 32; ++i) { ck32[i] = 0u; cp32[i] = 0u; }
        make_cands(top0, top1, f1, f2, hh, ck32, cp32);
        unsigned ck[2][16], cp[2][16];
#pragma unroll
        for (int i = 0; i < 16; ++i) { ck[0][i] = ck32[i]; cp[0][i] = cp32[i]; ck[1][i] = ck32[16 + i]; cp[1][i] = cp32[16 + i]; }
        sort16_desc2(ck[0], cp[0]); sort16_desc2(ck[1], cp[1]); merge_top16_2(ck[0], cp[0], ck[1], cp[1]);
        unsigned pk[16], pp[16];
#pragma unroll
        for (int i = 0; i < 16; ++i) { pk[i] = (unsigned)__shfl_xor((int)ck[0][i], 32); pp[i] = (unsigned)__shfl_xor((int)cp[0][i], 32); }
        merge_top16_2(ck[0], cp[0], pk, pp);
        float ss = 0.f; { const f32x4* sp = (const f32x4*)(ssq + (size_t)t * 64);
#pragma unroll
            for (int i = 0; i < 16; ++i) { const f32x4 v = sp[i]; ss += (v[0] + v[1]) + (v[2] + v[3]); } }
        const float rstd = rsqrtf(ss * (1.f / DM) + EPS);
        float ez[16]; float den = 0.f; const float z0 = key2f(ck[0][0]);
#pragma unroll
        for (int i = 0; i < 16; ++i) { ez[i] = __expf((key2f(ck[0][i]) - z0) * rstd); den += ez[i]; }
        const float inv = 1.f / den;
        int* ep = EIDX + (size_t)t * PK + h * TOPK; float* gp = GATE + (size_t)t * PK + h * TOPK;
        if (hh == 0) {
            *(u32x4*)(ep) = (u32x4){cp[0][0], cp[0][1], cp[0][2], cp[0][3]}; *(u32x4*)(ep + 4) = (u32x4){cp[0][4], cp[0][5], cp[0][6], cp[0][7]};
            *(f32x4*)(gp) = (f32x4){ez[0] * inv, ez[1] * inv, ez[2] * inv, ez[3] * inv}; *(f32x4*)(gp + 4) = (f32x4){ez[4] * inv, ez[5] * inv, ez[6] * inv, ez[7] * inv};
        } else {
            *(u32x4*)(ep + 8) = (u32x4){cp[0][8], cp[0][9], cp[0][10], cp[0][11]}; *(u32x4*)(ep + 12) = (u32x4){cp[0][12], cp[0][13], cp[0][14], cp[0][15]};
            *(f32x4*)(gp + 8) = (f32x4){ez[8] * inv, ez[9] * inv, ez[10] * inv, ez[11] * inv}; *(f32x4*)(gp + 12) = (f32x4){ez[12] * inv, ez[13] * inv, ez[14] * inv, ez[15] * inv};
        }
}
__device__ __forceinline__ void phase_topk2(const bf16_t* __restrict__ QH, const bf16_t* __restrict__ QL, const bf16_t* __restrict__ SKH, const bf16_t* __restrict__ SKL, const float* __restrict__ ssq,
                                            int* __restrict__ EIDX, float* __restrict__ GATE, int vcu, int G) {
    const int lane = threadIdx.x & 63, tok = lane & 31, hh = lane >> 5, gw = vcu * 8 + __builtin_amdgcn_readfirstlane(threadIdx.x >> 6), NGW = G * 8;
    for (int it = gw; it < PH * (S / 32); it += NGW) {
        int h = it & 7; asm volatile("" : "+s"(h));
        topk_item(QH, QL, SKH, SKL, ssq, EIDX, GATE, h, (it >> 3) * 32, tok, hh);
    }
}
template <class Sched>
__device__ __forceinline__ void phase_topk2_tiles(const bf16_t* __restrict__ QH, const bf16_t* __restrict__ QL, const bf16_t* __restrict__ SKH, const bf16_t* __restrict__ SKL, const float* __restrict__ ssq,
                                                  int* __restrict__ EIDX, float* __restrict__ GATE, const Sched& Sc) {
    const int lane = threadIdx.x & 63, tok = lane & 31, hh = lane >> 5, w = __builtin_amdgcn_readfirstlane(threadIdx.x >> 6);
    pg8::Tile u;
    for (int i = 0; Sc.next(i, u); ++i) { int h = u.pn; asm volatile("" : "+s"(h)); topk_item(QH, QL, SKH, SKL, ssq, EIDX, GATE, h, u.pm * 256 + 32 * w, tok, hh); }
}
}
namespace p0 {
template <int CTRL> __device__ __forceinline__ float dppf(float v) { return __builtin_bit_cast(float, __builtin_amdgcn_update_dpp(0, __builtin_bit_cast(int, v), CTRL, 0xf, 0xf, true)); }
__device__ __forceinline__ float rl(float v, int l) { return __builtin_bit_cast(float, __builtin_amdgcn_readlane(__builtin_bit_cast(int, v), l)); }
__device__ __forceinline__ float wsum_u(float v) { v += dppf<0xB1>(v); v += dppf<0x4E>(v); v += dppf<0x141>(v); v += dppf<0x140>(v); return (rl(v, 0) + rl(v, 16)) + (rl(v, 32) + rl(v, 48)); }
__device__ __forceinline__ float wmax_u(float v) { v = fmaxf(v, dppf<0xB1>(v)); v = fmaxf(v, dppf<0x4E>(v)); v = fmaxf(v, dppf<0x141>(v)); v = fmaxf(v, dppf<0x140>(v)); return fmaxf(fmaxf(rl(v, 0), rl(v, 16)), fmaxf(rl(v, 32), rl(v, 48))); }
__device__ __forceinline__ unsigned pk2(float lo, float hi) { return (unsigned)f2bf(lo) | ((unsigned)f2bf(hi) << 16); }
struct TrDesc { const float* src; bf16_t* dst; int ldw, pitch, split; };
__device__ __forceinline__ void tr_load(const TrDesc& d, int lane, float (&r)[32]) {
    const int l = lane & 31, adj = l >= d.split ? NHB : 0; const float* s = d.src + (size_t)(lane >> 5) * d.ldw + l + adj;
#pragma unroll
    for (int i = 0; i < 32; ++i) r[i] = s[(size_t)(2 * i) * d.ldw];
}
__device__ __forceinline__ void tr_store(const TrDesc& d, int lane, const float (&r)[32], LAS float* scr) {
#pragma unroll
    for (int i = 0; i < 32; ++i) scr[(2 * i + (lane >> 5)) * 33 + (lane & 31)] = r[i];
    asm volatile("s_waitcnt lgkmcnt(0)" ::: "memory");
    const int c = lane & 7;
#pragma unroll
    for (int j = 0; j < 4; ++j) { const int n = (lane >> 3) + 8 * j; const LAS float* s = scr + (8 * c) * 33 + n;
        uint4 o; o.x = pk2(s[0 * 33], s[1 * 33]); o.y = pk2(s[2 * 33], s[3 * 33]); o.z = pk2(s[4 * 33], s[5 * 33]); o.w = pk2(s[6 * 33], s[7 * 33]);
        *(uint4*)(d.dst + (size_t)n * d.pitch + 8 * c) = o; }
    asm volatile("s_waitcnt lgkmcnt(0)" ::: "memory");
}
struct Args { const float *x, *g1, *w_in, *bfg, *wua, *wub, *wout, *wq, *pu, *pv, *sk; bf16_t *WUT, *WOT, *WQT, *UB, *VB; float* LOGF; bf16_t *SKH, *SKL; unsigned char *XN8, *W8; float *XS, *WS8; float* WFC; unsigned* WFM; };
constexpr int I_1 = 0  , I_UA = 12 * 128, I_UB = 28 * 128, I_O = 64 * 128, I_Q = 64 * 64, NITEMS = I_1 + I_UA + I_UB + I_O + I_Q;
__device__ __forceinline__ TrDesc decode(const Args& a, int it);
__device__ __forceinline__ void transpose_range(const Args& a, LAS float* scr, int lane, int it0, int step, int it_end) {
    float ra[32], rb[32]; int it = it0; TrDesc d0{}, d1{};
    if (it < it_end) { d0 = decode(a, it); tr_load(d0, lane, ra); }
    while (it < it_end) { const int itn = it + step; const bool more = itn < it_end;
        if (more) { d1 = decode(a, itn); tr_load(d1, lane, rb); }
        tr_store(d0, lane, ra, scr);
        if (more) { d0 = d1;
#pragma unroll
            for (int i = 0; i < 32; ++i) ra[i] = rb[i]; }
        it = itn; }
}
__device__ __forceinline__ void prep(const Args& a, LAS unsigned char* lds, int bx, int G, int c_lo, int c_hi) {
    const int tid = threadIdx.x, lane = tid & 63, wave = __builtin_amdgcn_readfirstlane(tid >> 6), gw = bx * 8 + wave, NGW = G * 8;
    LAS float* scr = (LAS float*)(lds + wave * 8448);
    const int nrow = (2 * NEXP + NGW - 1) / NGW, nit = (NITEMS - I_1 + NGW - 1) / NGW;
    for (int c = c_lo; c < c_hi; ++c) {
        { const int j0 = (nrow * c) / 8, j1 = (nrow * (c + 1)) / 8; float4 va[16];
          for (int j = j0; j < j1; ++j) { const int row = gw + NGW * j; if (row < 2 * NEXP) { pr::tq_load(a.pu, a.pv, row, lane, va); pr::tq_pack((unsigned char*)a.UB, (float*)a.VB, row, lane, va); } } }
        { const int j0 = (nit * c) / 8, j1 = (nit * (c + 1)) / 8; if (j1 > j0) transpose_range(a, scr, lane, I_1 + gw + NGW * j0, NGW, (I_1 + gw + NGW * j1) < NITEMS ? (I_1 + gw + NGW * j1) : NITEMS); }
        if (c == 0) for (int i = bx * 512 + tid; i < PH * 2 * NKEYS * PQH; i += G * 512) { const float v = a.sk[i]; const bf16_t hb = f2bf(v); a.SKH[i] = hb; a.SKL[i] = f2bf(v - bf2f(hb)); }
    }
}
__device__ __forceinline__ void gate_w8(const Args& a, LAS unsigned char* lds, int bx, int G) {
    const int tid = threadIdx.x, lane = tid & 63, wave = __builtin_amdgcn_readfirstlane(tid >> 6), c = tid & 15, g = tid >> 4;
    constexpr int P = DM + 16;
    LAS unsigned char* T = lds; LAS float* cm = (LAS float*)(lds + 16 * P);
    const int half = (bx >> 3) & 1, bi = ((bx >> 4) << 3) | (bx & 7), nbase = G >> 1; const bool paired = (G & 15) == 0;
    auto blk = [&](int pj) -> int { return paired ? 2 * (bi + nbase * pj) + half : bx + G * pj; };
    auto srcof = [&](int cb) -> const float* { const int n0 = 16 * cb, n1 = n0 - 2 * (WA + WB);
        const int sc = n0 < 2 * WA ? n0 : (n1 < 0 ? C_QB + n0 - 2 * WA : (n1 < WA ? C_VA + n1 : (n1 < WA + WB ? C_VB + n1 - WA : C_GA + n1 - WA - WB)));
        return a.w_in + (size_t)(4 * g) * INC + sc + c; };
    constexpr int NB = (INC - NHB) / 16;
    float v[32][4];
    if (blk(0) < NB) { const float* src = srcof(blk(0));
#pragma unroll
        for (int i = 0; i < 32; ++i)
#pragma unroll
            for (int j = 0; j < 4; ++j) v[i][j] = src[(size_t)(128 * i + j) * INC]; }
    for (int pj = 0;; ++pj) { const int cb = blk(pj); if (cb >= NB) break; const int n0 = 16 * cb;
        float mx = 0.f;
#pragma unroll
        for (int i = 0; i < 32; ++i)
#pragma unroll
            for (int j = 0; j < 4; ++j) mx = fmaxf(mx, fabsf(v[i][j]));
        mx = fmaxf(mx, __shfl_xor(mx, 16)); mx = fmaxf(mx, __shfl_xor(mx, 32));
        if (lane < 16) cm[wave * 16 + lane] = mx;
        __syncthreads();
        float m = cm[c];
#pragma unroll
        for (int w = 1; w < 8; ++w) m = fmaxf(m, cm[w * 16 + c]);
        const float iv = m > 0.f ? 127.f / m : 0.f;
        if (tid < 16) a.WS8[n0 + tid] = m * (1.f / 127.f);
#pragma unroll
        for (int i = 0; i < 32; ++i) { unsigned pk = 0;
#pragma unroll
            for (int j = 0; j < 4; ++j) pk |= ((unsigned)__float2int_rn(v[i][j] * iv) & 0xffu) << (8 * j);
            *(LAS unsigned*)(T + c * P + 128 * i + 4 * g) = pk; }
        __syncthreads();
        { const int cbn = blk(pj + 1); if (cbn < NB) { const float* src = srcof(cbn);
#pragma unroll
            for (int i = 0; i < 32; ++i)
#pragma unroll
                for (int j = 0; j < 4; ++j) v[i][j] = src[(size_t)(128 * i + j) * INC]; } }
        asm volatile("" ::: "memory");
#pragma unroll
        for (int j = 0; j < 8; ++j) { const int q = tid + 512 * j, cc = q >> 8, off = (q & 255) * 16;
            *(pg8::u32x4*)(a.W8 + (size_t)(n0 + cc) * DM + off) = *(const LAS pg8::u32x4*)(T + cc * P + off); }
        __syncthreads();
    }
}
__device__ __forceinline__ void run(const Args& a, LAS unsigned char* lds, int vcu, int G) {
    const int tid = threadIdx.x, lane = tid & 63, wave = __builtin_amdgcn_readfirstlane(tid >> 6);
    const int gw = vcu * 8 + wave, NGW = G * 8;
    LAS float* scr = (LAS float*)(lds + wave * 8448);
    gate_w8(a, lds, blockIdx.x, G);
    __syncthreads();
    for (int k = blockIdx.x * 512 + tid; k < DM; k += G * 512) { const float2* src = (const float2*)(a.w_in + (size_t)k * INC + C_F);
#pragma unroll
        for (int j = 0; j < 7; ++j) { const float2 v = src[j]; a.WFC[(2 * j) * DM + k] = v.x; a.WFC[(2 * j + 1) * DM + k] = v.y;
            const float m0 = wmax_u(fabsf(v.x)), m1 = wmax_u(fabsf(v.y));
            if (lane == 0) { atomicMax(a.WFM + 2 * j, __float_as_uint(m0)); atomicMax(a.WFM + 2 * j + 1, __float_as_uint(m1)); } } }
    for (int m = gw; m < S; m += NGW) {
        const float4* xr = (const float4*)(a.x + (size_t)m * DM); float v[8][8]; float ss = 0.f;
#pragma unroll
        for (int j = 0; j < 8; ++j) { const float4 p = xr[j * 128 + 2 * lane], q = xr[j * 128 + 2 * lane + 1];
            v[j][0] = p.x; v[j][1] = p.y; v[j][2] = p.z; v[j][3] = p.w; v[j][4] = q.x; v[j][5] = q.y; v[j][6] = q.z; v[j][7] = q.w;
            ss += (p.x * p.x + p.y * p.y) + (p.z * p.z + p.w * p.w) + (q.x * q.x + q.y * q.y) + (q.z * q.z + q.w * q.w); }
        const float rstd = rsqrtf(wsum_u(ss) * (1.f / DM) + EPS);
#pragma unroll
        for (int j = 0; j < 8; ++j) { const float4 p = ((const float4*)a.g1)[j * 128 + 2 * lane], q = ((const float4*)a.g1)[j * 128 + 2 * lane + 1];
            v[j][0] *= rstd * p.x; v[j][1] *= rstd * p.y; v[j][2] *= rstd * p.z; v[j][3] *= rstd * p.w; v[j][4] *= rstd * q.x; v[j][5] *= rstd * q.y; v[j][6] *= rstd * q.z; v[j][7] *= rstd * q.w;
        }
        { float am = 0.f;
#pragma unroll
          for (int j = 0; j < 8; ++j)
#pragma unroll
              for (int e = 0; e < 8; ++e) am = fmaxf(am, fabsf(v[j][e]));
          am = wmax_u(am); const float iv = am > 0.f ? 127.f / am : 0.f;
#pragma unroll
          for (int j = 0; j < 8; ++j) { unsigned lo = 0, hi = 0;
#pragma unroll
              for (int b = 0; b < 4; ++b) { lo |= ((unsigned)__float2int_rn(v[j][b] * iv) & 0xffu) << (8 * b); hi |= ((unsigned)__float2int_rn(v[j][4 + b] * iv) & 0xffu) << (8 * b); }
              *(uint2*)(a.XN8 + (size_t)m * DM + j * 512 + 8 * lane) = make_uint2(lo, hi); }
          if (lane == 0) a.XS[m] = am * (1.f / 127.f); }
    }
}
__device__ __forceinline__ void flogits(const Args& a, LAS unsigned char* lds, int vcu, int G) {
    const int tid = threadIdx.x, lane = tid & 63, wave = __builtin_amdgcn_readfirstlane(tid >> 6), gw = vcu * 8 + wave, NGW = G * 8;
    for (int i = tid; i < NHB * (DM / 4); i += 512) { const int h = i / (DM / 4), k4 = i % (DM / 4); const float m = __uint_as_float(a.WFM[h]); const float iv = m > 0.f ? 127.f / m : 0.f;
        const float4 v = *(const float4*)(a.WFC + (size_t)h * DM + 4 * k4);
        *(LAS unsigned*)(lds + h * DM + 4 * k4) = ((unsigned)__float2int_rn(v.x * iv) & 0xffu) | (((unsigned)__float2int_rn(v.y * iv) & 0xffu) << 8) | (((unsigned)__float2int_rn(v.z * iv) & 0xffu) << 16) | ((unsigned)__float2int_rn(v.w * iv) << 24); }
    __syncthreads();
    const float ws = lane < NHB ? __uint_as_float(a.WFM[lane]) * (1.f / 127.f) : 0.f, bf = lane < NHB ? a.bfg[lane] : 0.f;
    pg8::u32x4 xn_[4];
    if (gw < S) {
#pragma unroll
        for (int j = 0; j < 4; ++j) xn_[j] = *(const pg8::u32x4*)(a.XN8 + (size_t)gw * DM + j * 1024 + lane * 16); }
    for (int m = gw; m < S; m += NGW) {
        pg8::u32x4 xr[4];
#pragma unroll
        for (int j = 0; j < 4; ++j) xr[j] = xn_[j];
        if (m + NGW < S) {
#pragma unroll
            for (int j = 0; j < 4; ++j) xn_[j] = *(const pg8::u32x4*)(a.XN8 + (size_t)(m + NGW) * DM + j * 1024 + lane * 16); }
        const float xs = a.XS[m]; int dl = 0;
#pragma unroll 2
        for (int h = 0; h < NHB; ++h) { int d = 0;
#pragma unroll
            for (int j = 0; j < 4; ++j) { const pg8::u32x4 w = *(const LAS pg8::u32x4*)(lds + h * DM + j * 1024 + lane * 16);
#pragma unroll
                for (int q = 0; q < 4; ++q) d = __builtin_amdgcn_sdot4((int)xr[j][q], (int)w[q], d, false); }
            d = pr::wave_sum_i_u(d); dl = (lane == h) ? d : dl; }
        if (lane < NHB) { const float z = (float)dl * xs * ws + bf; a.LOGF[m * 16 + lane] = fminf(z, 0.f) - log1pf(expf(-fabsf(z))); }
    }
    __syncthreads();
}
__device__ __forceinline__ TrDesc decode(const Args& a, int it) { int r = it; TrDesc d;
    if (r < I_UA) { const int kb = r / 128, nb = r % 128; d.src = a.wua + (size_t)(64 * kb) * DM + 32 * nb; d.ldw = DM; d.split = 32; d.dst = a.WUT + (size_t)(32 * nb) * YW + 64 * kb; d.pitch = YW; return d; } r -= I_UA;
    if (r < I_UB) { const int kb = r / 128, nb = r % 128; d.src = a.wub + (size_t)(64 * kb) * DM + 32 * nb; d.ldw = DM; d.split = 32; d.dst = a.WUT + WAO + (size_t)(32 * nb) * YW + 64 * kb; d.pitch = YW; return d; } r -= I_UB;
    if (r < I_O) { const int kb = r / 128, nb = r % 128; d.src = a.wout + (size_t)(64 * kb) * DM + 32 * nb; d.ldw = DM; d.split = 32; d.dst = a.WOT + (size_t)(32 * nb) * DM + 64 * kb; d.pitch = DM; return d; } r -= I_O;
    { const int kb = r / 64, nb = r % 64; d.src = a.wq + (size_t)(64 * kb) * PQW + 32 * nb; d.ldw = PQW; d.split = 32; d.dst = a.WQT + (size_t)(32 * nb) * DM + 64 * kb; d.pitch = DM; return d; } }
}
namespace att {
typedef short bf16x8 __attribute__((ext_vector_type(8)));
typedef short s16x4 __attribute__((ext_vector_type(4)));
typedef float f32x16 __attribute__((ext_vector_type(16)));
typedef float f32x4 __attribute__((ext_vector_type(4)));
typedef unsigned u32x4 __attribute__((ext_vector_type(4)));
typedef unsigned u32x2 __attribute__((ext_vector_type(2)));
constexpr int KOFF = 0, VOFF = 32768, COFF = 65536, LDS_BYTES = 66048;
struct Unit { const char* q; const char* k; const char* v; size_t pitch; int i0; const float* c2; float slope2; char* o; size_t opitch; float* mo; float* lo; int mpitch; float thr; };
#define ATT_MFMA(a, b, c) __builtin_amdgcn_mfma_f32_32x32x16_bf16((a), (b), (c), 0, 0, 0)
__device__ __forceinline__ unsigned pk_bf16(float lo, float hi) { return pg8::cvt_pk_bf16(lo, hi); }

template <bool FOX>
__device__ __forceinline__ void unit(LAS unsigned char* lds, const Unit& u) {
    const int tid = threadIdx.x, w = __builtin_amdgcn_readfirstlane(tid >> 6), lane = tid & 63, c = lane & 31, h = lane >> 5;
    const int imin = u.i0 + 32 * w, imax = imin + 31, irow = imin + c;
    int T_lo = (u.i0 - 128 > 0 ? u.i0 - 128 : 0) >> 6; const int T_hi = (u.i0 + 255) >> 6;
    if (FOX) {
        const int nT = u.i0 >> 6; const float c0 = u.c2[u.i0]; T_lo = nT;
        for (int base = 0; base < nT; base += 64) { const int tl = base + lane; const bool keep = (tl < nT) ? (c0 - u.c2[64 * tl + 63] > -u.thr) : true;
            const unsigned long long bm = __ballot(keep); if (bm) { const int f = base + __ffsll((long long)bm) - 1; T_lo = f < nT ? f : nT; break; } }
        T_lo = __builtin_amdgcn_readfirstlane(T_lo);
    }
    const int w_lo = FOX ? T_lo : ((imin - 128 > 0 ? imin - 128 : 0) >> 6), w_hi = imax >> 6;
    const int dr = lane >> 4, dp = lane & 15;
    unsigned ksrc[2], vsrc[2];
#pragma unroll
    for (int j = 0; j < 2; ++j) { const int row = 8 * w + 4 * j + dr; ksrc[j] = (unsigned)(row * u.pitch) + ((dp ^ (row & 15)) << 4); vsrc[j] = (unsigned)(row * u.pitch) + ((dp ^ ((row & 3) << 2)) << 4); }
    const size_t tstep = 64 * u.pitch;
#define ATT_ISSUE(T, b) do { const char* kb_ = u.k + (size_t)(T) * tstep; const char* vb_ = u.v + (size_t)(T) * tstep; \
        _Pragma("unroll") for (int j_ = 0; j_ < 2; ++j_) { \
            __builtin_amdgcn_global_load_lds((const unsigned*)(kb_ + ksrc[j_]), (LAS unsigned*)(lds + KOFF + (b) * 16384 + (8 * w + 4 * j_) * 256), 16, 0, 0); \
            __builtin_amdgcn_global_load_lds((const unsigned*)(vb_ + vsrc[j_]), (LAS unsigned*)(lds + VOFF + (b) * 16384 + (8 * w + 4 * j_) * 256), 16, 0, 0); } \
        if (FOX && w == 0) __builtin_amdgcn_global_load_lds((const unsigned*)(u.c2 + (T) * 64 + lane), (LAS unsigned*)(lds + COFF + (b) * 256), 4, 0, 0); } while (0)
    int koff[8], voff[4];
#pragma unroll
    for (int ks = 0; ks < 8; ++ks) koff[ks] = c * 256 + (((2 * ks + h) ^ (lane & 15)) << 4);
    { const int q4 = (lane & 15) >> 2, gi = (lane >> 4) & 1, p = lane & 3;
#pragma unroll
      for (int dg = 0; dg < 4; ++dg) voff[dg] = (4 * h + q4) * 256 + ((4 * (dg ^ q4) + 2 * gi + (p >> 1)) << 4) + 8 * (p & 1); }
    bf16x8 qf[8];
    { const char* qrow = u.q + (size_t)irow * u.pitch + h * 16;
#pragma unroll
      for (int ks = 0; ks < 8; ++ks) qf[ks] = *(const bf16x8*)(qrow + ks * 32); }
    const float ci = FOX ? u.c2[irow] : 0.f;
    float m = -1e30f, l = 0.f;
    f32x16 O[4];
#pragma unroll
    for (int dg = 0; dg < 4; ++dg)
#pragma unroll
        for (int r = 0; r < 16; ++r) O[dg][r] = 0.f;
    asm volatile("" ::: "memory"); __builtin_amdgcn_s_barrier(); asm volatile("" ::: "memory");
    ATT_ISSUE(T_lo, 0);
    int b = 0;
    for (int T = T_lo; T <= T_hi; ++T, b ^= 1) {
        asm volatile("s_waitcnt vmcnt(0)" ::: "memory");
        __builtin_amdgcn_s_barrier(); asm volatile("" ::: "memory");
        if (T < T_hi) ATT_ISSUE(T + 1, b ^ 1);
        if (T < w_lo || T > w_hi) continue;
        const LAS unsigned char* kb = lds + KOFF + b * 16384; const LAS unsigned char* vb = lds + VOFF + b * 16384;
        f32x16 S0, S1;
#pragma unroll
        for (int r = 0; r < 16; ++r) { S0[r] = 0.f; S1[r] = 0.f; }
#pragma unroll
        for (int ks = 0; ks < 8; ++ks) { const bf16x8 k0 = *(const LAS bf16x8*)(kb + koff[ks]), k1 = *(const LAS bf16x8*)(kb + 8192 + koff[ks]);
            S0 = ATT_MFMA(k0, qf[ks], S0); S1 = ATT_MFMA(k1, qf[ks], S1); }
        const int j0 = T * 64 + 4 * h;
        if (FOX) { const LAS float* cb = (const LAS float*)(lds + COFF + b * 256) + 4 * h;
#pragma unroll
            for (int g4 = 0; g4 < 4; ++g4) { const f32x4 c0 = *(const LAS f32x4*)(cb + 8 * g4), c1 = *(const LAS f32x4*)(cb + 32 + 8 * g4);
#pragma unroll
                for (int e = 0; e < 4; ++e) { S0[4 * g4 + e] += ci - c0[e]; S1[4 * g4 + e] += ci - c1[e]; } }
        } else { const float d0 = u.slope2 * (float)(j0 - irow);
#pragma unroll
            for (int r = 0; r < 16; ++r) { S0[r] += d0 + u.slope2 * (float)((r & 3) + 8 * (r >> 2)); S1[r] += d0 + u.slope2 * (float)(32 + (r & 3) + 8 * (r >> 2)); } }
        const bool need_mask = (T * 64 + 63 > imin) || (!FOX && T * 64 < imax - 128);
        if (need_mask) { const unsigned lim = FOX ? 0x7fffffffu : 128u; const int dj = irow - j0;
#pragma unroll
            for (int r = 0; r < 16; ++r) { const int kk = (r & 3) + 8 * (r >> 2);
                S0[r] = ((unsigned)(dj - kk) <= lim) ? S0[r] : -INFINITY; S1[r] = ((unsigned)(dj - kk - 32) <= lim) ? S1[r] : -INFINITY; } }
        float mx = fmaxf(S0[0], S1[0]);
#pragma unroll
        for (int r = 1; r < 16; ++r) mx = fmaxf(mx, fmaxf(S0[r], S1[r]));
        mx = fmaxf(mx, __shfl_xor(mx, 32));
        const float mn = fmaxf(m, mx), alpha = __builtin_amdgcn_exp2f(m - mn); m = mn;
        float ps = 0.f;
#pragma unroll
        for (int r = 0; r < 16; ++r) { S0[r] = __builtin_amdgcn_exp2f(S0[r] - mn); S1[r] = __builtin_amdgcn_exp2f(S1[r] - mn); ps += S0[r] + S1[r]; }
        l = l * alpha + ps;
#pragma unroll
        for (int dg = 0; dg < 4; ++dg)
#pragma unroll
            for (int r = 0; r < 16; ++r) O[dg][r] *= alpha;
        bf16x8 pf[4];
#pragma unroll
        for (int s = 0; s < 4; ++s) { u32x4 pk;
#pragma unroll
            for (int e = 0; e < 4; ++e) { const int r = 8 * (s & 1) + 2 * e; pk[e] = (s < 2) ? pk_bf16(S0[r], S0[r + 1]) : pk_bf16(S1[r], S1[r + 1]); }
            pf[s] = __builtin_bit_cast(bf16x8, pk); }
#pragma unroll
        for (int s = 0; s < 4; ++s)
#pragma unroll
            for (int dg = 0; dg < 4; ++dg) {
                const s16x4 lo = __builtin_amdgcn_ds_read_tr16_b64_v4i16((LAS s16x4*)(vb + voff[dg] + s * 4096));
                const s16x4 hi = __builtin_amdgcn_ds_read_tr16_b64_v4i16((LAS s16x4*)(vb + voff[dg] + s * 4096 + 2048));
                const bf16x8 vf = __builtin_shufflevector(lo, hi, 0, 1, 2, 3, 4, 5, 6, 7);
                O[dg] = ATT_MFMA(vf, pf[s], O[dg]); }
    }
    const float lt = l + __shfl_xor(l, 32), inv = 1.f / lt;
    char* orow = u.o + (size_t)irow * u.opitch + h * 8;
#pragma unroll
    for (int dg = 0; dg < 4; ++dg)
#pragma unroll
        for (int g4 = 0; g4 < 4; ++g4) { u32x2 wv; wv.x = pk_bf16(O[dg][4 * g4] * inv, O[dg][4 * g4 + 1] * inv); wv.y = pk_bf16(O[dg][4 * g4 + 2] * inv, O[dg][4 * g4 + 3] * inv);
            *(u32x2*)(orow + dg * 64 + g4 * 16) = wv; }
    if (!FOX && h == 0) { u.mo[(size_t)irow * u.mpitch] = m; u.lo[(size_t)irow * u.mpitch] = lt; }
#undef ATT_ISSUE
}
__device__ __forceinline__ void scan_head(const float* __restrict__ logf, float* __restrict__ c2, int h, LAS float* part) {
    const int tid = threadIdx.x; float v[16]; float s = 0.f;
#pragma unroll
    for (int i = 0; i < 16; ++i) { s += logf[(tid * 16 + i) * 16 + h]; v[i] = s; }
    part[tid] = s; __syncthreads();
    for (int o = 1; o < 512; o <<= 1) { const float t = (tid >= o) ? part[tid - o] : 0.f; __syncthreads(); part[tid] += t; __syncthreads(); }
    const float base = tid ? part[tid - 1] : 0.f;
#pragma unroll
    for (int i = 0; i < 16; ++i) c2[(size_t)h * S + tid * 16 + i] = (base + v[i]) * LOG2E;
    __syncthreads();
}
__device__ __forceinline__ void phase_a(LAS unsigned char* lds, const bf16_t* QA, const bf16_t* KA, const bf16_t* VA, bf16_t* OA, float* MA, float* LA, int vcu, int G) {
    for (int it = vcu; it < NHA * 32; it += G) {
        const int hd = it >> 5, uu = it & 31, g = hd / 6, r = group_dil(g), nper = 32 / r, cc = uu / nper, n = uu % nper;
        Unit u; const size_t off = ((size_t)cc * WA + hd * HD) * 2;
        u.q = (const char*)QA + off; u.k = (const char*)KA + off; u.v = (const char*)VA + off; u.pitch = (size_t)r * WA * 2; u.i0 = n * 256; u.c2 = nullptr;
        u.slope2 = exp2f(-8.f * (float)(hd + 1) / 18.f) * (float)r * LOG2E; u.o = (char*)OA + off; u.opitch = u.pitch; u.mo = MA + cc * NHA + hd; u.lo = LA + cc * NHA + hd; u.mpitch = r * NHA; u.thr = 0.f;
        unit<false>(lds, u);
    }
}
__device__ __forceinline__ void phase_b(LAS unsigned char* lds, const bf16_t* QB, const bf16_t* KB, const bf16_t* VB, const float* C2, bf16_t* Y, const float* gq, const float* gk, int vcu, int G) {
    float thr; { const int lane = threadIdx.x & 63; const float a = wave_max(fmaxf(fabsf(gq[lane]), fabsf(gq[lane + 64]))), b = wave_max(fmaxf(fabsf(gk[lane]), fabsf(gk[lane + 64]))); thr = 38.f + 2.f * (128.f * QSCALE * a * b); }
    for (int pass = 0; pass * G < NHB * 32; ++pass) {
        const int idx = (pass & 1) ? (pass + 1) * G - 1 - vcu : pass * G + vcu; if (idx >= NHB * 32) continue;
        const int blk = 31 - idx / NHB, hd = idx % NHB;
        Unit u; u.q = (const char*)QB + hd * HD * 2; u.k = (const char*)KB + hd * HD * 2; u.v = (const char*)VB + hd * HD * 2; u.pitch = (size_t)WB * 2; u.i0 = blk * 256; u.c2 = C2 + (size_t)hd * S;
        u.slope2 = 0.f; u.o = (char*)Y + (WAO + hd * HD) * 2; u.opitch = (size_t)YW * 2; u.mo = nullptr; u.lo = nullptr; u.mpitch = 0; u.thr = thr;
        unit<true>(lds, u);
    }
}
__device__ __forceinline__ void phase_merge(const bf16_t* __restrict__ OA, const float* __restrict__ MA, const float* __restrict__ LA, bf16_t* __restrict__ Y, int vcu, int G) {
    const int lane = threadIdx.x & 63, gw = vcu * 8 + __builtin_amdgcn_readfirstlane(threadIdx.x >> 6), NGW = G * 8, sub = lane >> 4, dl = lane & 15;
#pragma unroll 2
    for (int it = gw; it < S * 6 / 4; it += NGW) { const int pr = it * 4 + sub, t = pr / 6, j = pr % 6;
        float mg[3], lg[3]; u32x4 ov[3];
#pragma unroll
        for (int g = 0; g < 3; ++g) { mg[g] = MA[t * NHA + g * 6 + j]; lg[g] = LA[t * NHA + g * 6 + j]; ov[g] = *(const u32x4*)(OA + (size_t)t * WA + (g * 6 + j) * HD + 8 * dl); }
        const float ms = fmaxf(mg[0], fmaxf(mg[1], mg[2]));
        float num[8], den = 0.f;
#pragma unroll
        for (int e = 0; e < 8; ++e) num[e] = 0.f;
#pragma unroll
        for (int g = 0; g < 3; ++g) { const float wl = exp2f(mg[g] - ms) * lg[g]; den += wl;
#pragma unroll
            for (int e = 0; e < 4; ++e) { num[2 * e] += wl * __uint_as_float(ov[g][e] << 16); num[2 * e + 1] += wl * __uint_as_float(ov[g][e] & 0xffff0000u); } }
        const float inv = 1.f / den; u32x4 o;
#pragma unroll
        for (int e = 0; e < 4; ++e) o[e] = pk_bf16(num[2 * e] * inv, num[2 * e + 1] * inv);
        *(u32x4*)(Y + (size_t)t * YW + j * HD + 8 * dl) = o; }
}
}
constexpr int MEGA_LDS = 147456;
constexpr int LDS_CTL_OFF = 131072 + 8192;
struct MArgs { const float* in[16]; float* out; unsigned char* ws; int ph_lo, ph_hi; };
__global__ void __launch_bounds__(512, 2) mega(MArgs a) {
    extern __shared__ __attribute__((aligned(16))) unsigned char lds_raw[];
    LAS unsigned char* lds = (LAS unsigned char*)lds_raw;
    const int tid = threadIdx.x, G = gridDim.x, bx = blockIdx.x;
    const int vcu = (G % 8 == 0) ? (bx % 8) * (G / 8) + bx / 8 : bx;
    unsigned char* ws = a.ws;
    volatile LAS unsigned* ctlw = (volatile LAS unsigned*)(lds + LDS_CTL_OFF);
    if (tid < 16) ctlw[tid] = 0u;
    __syncthreads();
    XcdBarrier bar = xcd_barrier_post((unsigned*)(ws + WS_CTL) + 4096, ctlw);
    const int lo = a.ph_lo, hi = a.ph_hi;
#define IN(k) (lo <= (k) && (k) < hi)
#define BOTH(k) (IN(k) && IN((k) + 1))
    p0::Args pa{a.in[0], a.in[1], a.in[2], a.in[3], a.in[8], a.in[9], a.in[10], a.in[12], a.in[14], a.in[15], a.in[13],
                (bf16_t*)(ws + WS_WUT), (bf16_t*)(ws + WS_WOT), (bf16_t*)(ws + WS_WQT), (bf16_t*)(ws + WS_UB), (bf16_t*)(ws + WS_VB), (float*)(ws + WS_LOGF), (bf16_t*)(ws + WS_WFT), (bf16_t*)(ws + WS_WFT) + PH * 2 * NKEYS * PQH,
                (unsigned char*)(ws + WS_XN8), (unsigned char*)(ws + WS_W8), (float*)(ws + WS_XS), (float*)(ws + WS_WS8), (float*)(ws + WS_LOGF + 512 * 1024), (unsigned*)(ws + WS_CTL) + 128};
    if (IN(0)) {
        p0::run(pa, lds, vcu, G);
        if (BOTH(0)) xcd_barrier(bar);
    }
    if (IN(1)) {
        pg8::Sched1 S1{(const char*)(ws + WS_XN8), (const char*)(ws + WS_W8), G, bx, 32, DM / 128, DM, DM};
        pg8::Epi1 E1{ws, (const float*)(ws + WS_XS), (const float*)(ws + WS_WS8), a.in[4], a.in[5], a.in[6], a.in[7]};
        p0::flogits(pa, lds, vcu, G);
        p0::prep(pa, lds, bx, G, 0, bx & 7);
        __syncthreads();
        pg8::gemm_phase<pg8::Epi1, pg8::Sched1, true>(lds, S1, E1);
        { pg8::Sched1 S8{(const char*)(ws + WS_XN8), (const char*)(ws + WS_W8) + (size_t)8192 * DM, G, bx, 48, DM / 128, DM, DM};
          pg8::EpiGate8 E8{ws, (const float*)(ws + WS_XS), (const float*)(ws + WS_WS8) + 8192};
          pg8::gemm_phase<pg8::EpiGate8, pg8::Sched1, true>(lds, S8, E8); }
        p0::prep(pa, lds, bx, G, bx & 7, 8);
        if (BOTH(1)) xcd_barrier(bar);
    }
    if (IN(2)) {
        if (bx < NHB) att::scan_head((const float*)(ws + WS_LOGF), (float*)(ws + WS_C2), bx, (LAS float*)lds);
        att::phase_a(lds, (const bf16_t*)(ws + WS_QA), (const bf16_t*)(ws + WS_KA), (const bf16_t*)(ws + WS_VAN), (bf16_t*)(ws + WS_OA), (float*)(ws + WS_MA), (float*)(ws + WS_LA), vcu, G);
        if (BOTH(2)) xcd_barrier(bar);
    }
    if (IN(3)) {
        att::phase_b(lds, (const bf16_t*)(ws + WS_QB), (const bf16_t*)(ws + WS_KB), (const bf16_t*)(ws + WS_VBN), (const float*)(ws + WS_C2), (bf16_t*)(ws + WS_Y), a.in[6], a.in[7], vcu, G);
        att::phase_merge((const bf16_t*)(ws + WS_OA), (const float*)(ws + WS_MA), (const float*)(ws + WS_LA), (bf16_t*)(ws + WS_Y), vcu, G);
        if (BOTH(3)) xcd_barrier(bar);
    }
    if (IN(4)) {
        pg8::SchedUp SU{(const char*)(ws + WS_Y), (const char*)(ws + WS_WUT), G, bx, YW * 2, YW * 2};
        pg8::EpiUp EU{(const unsigned char*)(ws + WS_GA), (const unsigned char*)(ws + WS_GB), (bf16_t*)(ws + WS_MERGED)};
        pg8::gemm_phase<pg8::EpiUp, pg8::SchedUp>(lds, SU, EU);
        if (BOTH(4)) xcd_barrier(bar);
    }
    if (IN(5)) {
        pg8::SchedPlain SO{(const char*)(ws + WS_MERGED), (const char*)(ws + WS_WOT), G, bx, 32, 16, DM, DM * 2, DM * 2};
        pg8::EpiOut EO{a.in[0], a.in[11], a.out, (bf16_t*)(ws + WS_XN), (float*)(ws + WS_SSQ)};
        pg8::gemm_phase<pg8::EpiOut, pg8::SchedPlain>(lds, SO, EO);
        if (BOTH(5)) xcd_barrier(bar);
    }
    if (IN(6)) {
        pg8::SchedPlain SQ{(const char*)(ws + WS_XN), (const char*)(ws + WS_WQT), G, bx, 32, 8, DM, DM * 2, DM * 2};
        pg8::EpiHiLo EQ{(bf16_t*)(ws + WS_QP), (bf16_t*)(ws + WS_QP) + (size_t)S * PQW, PQW, 0};
        pg8::gemm_phase<pg8::EpiHiLo, pg8::SchedPlain>(lds, SQ, EQ);
        tk::phase_topk2_tiles((const bf16_t*)(ws + WS_QP), (const bf16_t*)(ws + WS_QP) + (size_t)S * PQW, (const bf16_t*)(ws + WS_WFT), (const bf16_t*)(ws + WS_WFT) + PH * 2 * NKEYS * PQH, (const float*)(ws + WS_SSQ), (int*)(ws + WS_EIDX), (float*)(ws + WS_GATE), SQ);
        pr::quant_tokens((const bf16_t*)(ws + WS_XN), (unsigned char*)(ws + WS_MERGED), (float*)(ws + WS_MA), vcu * 8 + __builtin_amdgcn_readfirstlane(tid >> 6), G * 8, tid & 63);
        if (BOTH(6)) xcd_barrier(bar);
    }
    if (IN(8)) {
        if ((G & 7) == 0) {
            pr::phase_udot((const unsigned char*)(ws + WS_MERGED), (const int*)(ws + WS_EIDX), (const unsigned char*)(ws + WS_UB), (int*)(ws + WS_OA), bx, G);
            xcd_barrier(bar);
            pr::phase_vsum2((const int*)(ws + WS_OA), (const float*)(ws + WS_MA), (const float*)(ws + WS_SSQ), (const int*)(ws + WS_EIDX), (const float*)(ws + WS_GATE), (const unsigned char*)(ws + WS_UB) + (size_t)NEXP * DM,
                           (const float*)(ws + WS_VB), (const float*)(ws + WS_VB) + NEXP, a.out, vcu, G);
        } else {
            pr::phase_gather8((const bf16_t*)(ws + WS_XN), (const float*)(ws + WS_SSQ), (const int*)(ws + WS_EIDX), (const float*)(ws + WS_GATE), (const unsigned char*)(ws + WS_UB), (const unsigned char*)(ws + WS_UB) + (size_t)NEXP * DM,
                              (const float*)(ws + WS_VB), (const float*)(ws + WS_VB) + NEXP, a.out, vcu, G);
        }
    }
#undef IN
#undef BOTH
}
static int mega_grid() {
    static int grid = 0;
    if (!grid) { int dev = 0, cus = 0, per_cu = 0; hipGetDevice(&dev); hipDeviceGetAttribute(&cus, hipDeviceAttributeMultiprocessorCount, dev);
        hipFuncSetAttribute((const void*)mega, hipFuncAttributeMaxDynamicSharedMemorySize, MEGA_LDS);
        hipOccupancyMaxActiveBlocksPerMultiprocessor(&per_cu, (const void*)mega, 512, MEGA_LDS);
        if (per_cu < 1) fprintf(stderr, "mega: occupancy query says %d blocks per CU\n", per_cu);
        grid = cus; }
    return grid;
}
static void launch_mega(void* const* d_in, float* out, unsigned char* ws, hipStream_t st, int lo, int hi) {
    MArgs a{}; for (int i = 0; i < 16; ++i) a.in[i] = (const float*)d_in[i]; a.out = out; a.ws = ws; a.ph_lo = lo; a.ph_hi = hi;
    hipLaunchKernelGGL(mega, dim3(mega_grid()), dim3(512), MEGA_LDS, st, a);
}
extern "C" void kernel_launch(void* const* d_in, const int* in_sizes, int n_in, void* d_out, int out_size, void* d_ws, size_t ws_size, hipStream_t stream) {
    if (n_in != 16 || out_size != S * DM || ws_size < WS_END) { fprintf(stderr, "kernel_launch: unexpected sizes n_in %d out %d ws %zu\n", n_in, out_size, ws_size); return; }
    unsigned char* ws = (unsigned char*)d_ws;
    hipMemsetAsync(ws + WS_CTL, 0, 1 * MiB, stream);
    launch_mega(d_in, (float*)d_out, ws, stream, 0, 9);
}
```
